# Optimizing an MI355X kernel written in HIP

```python
import jax
import jax.numpy as jnp
from jax import lax
import numpy as np

D_MODEL = 2048
BATCH = 8
SEQ = 2048
DEPTH = 2

GRID_W = 64
CTX_LEN = 256
D_CONV = D_MODEL // 4
D_MLSTM = D_MODEL // 2
D_SHORT = D_MODEL // 4
MLSTM_HEADS = 8
MLSTM_HEAD_DIM = D_MLSTM // MLSTM_HEADS
MLSTM_CHUNK = 64
CONV_A_WIDTH = 31
CONV_C_WIDTH = 3
D_FF = 4 * D_MODEL
N_GATES = 4 * MLSTM_HEADS
D_IN = 2 * D_CONV + 4 * D_MLSTM + N_GATES + 3 * D_SHORT
SPLIT_POINTS = (
    D_CONV,
    2 * D_CONV,
    2 * D_CONV + D_MLSTM,
    2 * D_CONV + 2 * D_MLSTM,
    2 * D_CONV + 3 * D_MLSTM,
    2 * D_CONV + 4 * D_MLSTM,
    2 * D_CONV + 4 * D_MLSTM + N_GATES,
    2 * D_CONV + 4 * D_MLSTM + N_GATES + D_SHORT,
    2 * D_CONV + 4 * D_MLSTM + N_GATES + 2 * D_SHORT,
)
NORM_EPS = 1e-6

kernel_name = "hybrid_conformer_mlstm_shortconv_dit_block"


def _rms_norm(x, w):
    xf = x.astype(jnp.float32)
    y = xf * lax.rsqrt(jnp.mean(xf * xf, axis=-1, keepdims=True) + NORM_EPS)
    return (y * w.astype(jnp.float32)).astype(x.dtype)


def _layer_norm(x, w, b):
    xf = x.astype(jnp.float32)
    mu = jnp.mean(xf, axis=-1, keepdims=True)
    var = jnp.mean(jnp.square(xf - mu), axis=-1, keepdims=True)
    y = (xf - mu) * lax.rsqrt(var + NORM_EPS)
    return (y * w.astype(jnp.float32) + b.astype(jnp.float32)).astype(x.dtype)


def _depthwise_conv(x, w, b):
    pad = w.shape[0] // 2
    y = lax.conv_general_dilated(
        x, w[:, None, :].astype(x.dtype), window_strides=(1,), padding=[(pad, pad)],
        dimension_numbers=("NWC", "WIO", "NWC"), feature_group_count=x.shape[-1])
    return y + b


def _short_conv_axis1(x, w):
    k = w.shape[0]
    pad = k // 2
    n = x.shape[1]
    widths = [(0, 0)] * x.ndim
    widths[1] = (pad, pad)
    p = jnp.pad(x, widths)
    y = w[0] * lax.slice_in_dim(p, 0, n, axis=1)
    for tap in range(1, k):
        y = y + w[tap] * lax.slice_in_dim(p, tap, tap + n, axis=1)
    return y


def _conformer_conv(a_val, a_gate, conv_w, conv_b, ln_w, ln_b, rows):
    u = a_val * jax.nn.sigmoid(a_gate)
    bsz, n, ch = u.shape
    if rows is None:
        y = _depthwise_conv(u, conv_w, conv_b)
    else:
        y = _depthwise_conv(u.reshape(bsz * rows, GRID_W, ch), conv_w, conv_b).reshape(bsz, n, ch)
    return jax.nn.silu(_layer_norm(y, ln_w, ln_b))


def _gated_short_conv(s_in, s_b, s_c, conv_w, rows):
    u = s_c * s_in
    bsz, n, ch = u.shape
    if rows is None:
        y = _short_conv_axis1(u, conv_w)
    else:
        y = _short_conv_axis1(u.reshape(bsz, rows, GRID_W, ch), conv_w).reshape(bsz, n, ch)
    return s_b * y


def _mlstm_chunked(q, k, v, log_i, log_f, state):
    bsz, heads, t_len, dh = q.shape
    n_chunks = t_len // MLSTM_CHUNK

    def to_chunks(a):
        a = a.reshape(bsz, heads, n_chunks, MLSTM_CHUNK, *a.shape[3:])
        return jnp.moveaxis(a, 2, 0)

    mask = jnp.tril(jnp.ones((MLSTM_CHUNK, MLSTM_CHUNK), dtype=bool))

    def step(carry, inp):
        c_prev, n_prev, m_prev = carry
        qc, kc, vc, lic, lfc = inp
        b = jnp.cumsum(lfc, axis=-1)
        log_d = jnp.where(mask, b[..., :, None] - b[..., None, :] + lic[..., None, :], -jnp.inf)
        log_inter = b + m_prev[..., None]
        m_row = jnp.maximum(log_inter, jnp.max(log_d, axis=-1))
        w_intra = jnp.exp(log_d - m_row[..., None])
        w_inter = jnp.exp(log_inter - m_row)
        scores = jnp.einsum("bhjd,bhsd->bhjs", qc, kc) * w_intra
        num = (jnp.einsum("bhjs,bhse->bhje", scores, vc)
               + w_inter[..., None] * jnp.einsum("bhjd,bhde->bhje", qc, c_prev))
        den = jnp.sum(scores, axis=-1) + w_inter * jnp.einsum("bhjd,bhd->bhj", qc, n_prev)
        h = num / jnp.maximum(jnp.abs(den), jnp.exp(-m_row))[..., None]
        b_last = b[..., -1]
        log_w = b_last[..., None] - b + lic
        m_new = jnp.maximum(b_last + m_prev, jnp.max(log_w, axis=-1))
        w_tok = jnp.exp(log_w - m_new[..., None])
        decay = jnp.exp(b_last + m_prev - m_new)
        kw = kc * w_tok[..., None]
        c_new = decay[..., None, None] * c_prev + jnp.einsum("bhsd,bhse->bhde", kw, vc)
        n_new = decay[..., None] * n_prev + jnp.sum(kw, axis=2)
        return (c_new, n_new, m_new), h

    state, h = lax.scan(step, state, (to_chunks(q), to_chunks(k), to_chunks(v),
                                      to_chunks(log_i), to_chunks(log_f)))
    return jnp.moveaxis(h, 0, 2).reshape(bsz, heads, t_len, dh), state


def _heads(t):
    bsz, n, _ = t.shape
    return t.reshape(bsz, n, MLSTM_HEADS, MLSTM_HEAD_DIM).transpose(0, 2, 1, 3).astype(jnp.float32)


def _mlstm_prep(q, k, v, g, gate_b):
    g = (g.astype(jnp.float32) + gate_b.astype(jnp.float32)).transpose(0, 2, 1)
    i_f, f_f, i_b, f_b = jnp.split(g, 4, axis=1)
    return (_heads(q), _heads(k) * MLSTM_HEAD_DIM ** -0.5, _heads(v),
            i_f, jax.nn.log_sigmoid(f_f), i_b, jax.nn.log_sigmoid(f_b))


def _mlstm_bidirectional(lat, ctx_in):
    qx, kx, vx, ixf, fxf, ixb, fxb = lat
    qc, kc, vc, icf, fcf, icb, fcb = ctx_in
    bsz = qx.shape[0]
    zero = (jnp.zeros((bsz, MLSTM_HEADS, MLSTM_HEAD_DIM, MLSTM_HEAD_DIM), jnp.float32),
            jnp.zeros((bsz, MLSTM_HEADS, MLSTM_HEAD_DIM), jnp.float32),
            jnp.zeros((bsz, MLSTM_HEADS), jnp.float32))
    hc_f, st_f = _mlstm_chunked(qc, kc, vc, icf, fcf, zero)
    hx_f, _ = _mlstm_chunked(qx, kx, vx, ixf, fxf, st_f)
    rev = lambda t: jnp.flip(t, axis=2)
    hc_b, st_b = _mlstm_chunked(rev(qc), rev(kc), rev(vc), rev(icb), rev(fcb), zero)
    hx_b, _ = _mlstm_chunked(rev(qx), rev(kx), rev(vx), rev(ixb), rev(fxb), st_b)
    return hx_f + rev(hx_b), hc_f + rev(hc_b)


def _mlstm_out(h, o, norm_w):
    h = h.transpose(0, 2, 1, 3)
    mu = jnp.mean(h, axis=-1, keepdims=True)
    var = jnp.mean(jnp.square(h - mu), axis=-1, keepdims=True)
    h = (h - mu) * lax.rsqrt(var + NORM_EPS)
    bsz, n = h.shape[:2]
    h = h.reshape(bsz, n, D_MLSTM) * norm_w.astype(jnp.float32)
    return (h * jax.nn.sigmoid(o.astype(jnp.float32))).astype(o.dtype)


def _sq_relu_mlp(h, w_ff1, w_ff2):
    return jnp.square(jax.nn.relu(h @ w_ff1)) @ w_ff2


def _layer(x, ctx, c, c_ctx, w_ada, b_ada, g_pre_mix, g_post_mix, g_pre_ffn, g_post_ffn,
           w_in, b_gates, conv_a_w, conv_a_b, ln_a_w, ln_a_b, mlstm_norm_w, conv_c_w,
           w_out, w_ff1, w_ff2, rows, update_ctx):
    mod_x = (jax.nn.silu(c) @ w_ada + b_ada)[:, None, :]
    mod_c = (jax.nn.silu(c_ctx) @ w_ada + b_ada)[None, None, :]
    sh1x, sc1x, g1x, sh2x, sc2x, g2x = jnp.split(mod_x, 6, axis=-1)
    sh1c, sc1c, g1c, sh2c, sc2c, g2c = jnp.split(mod_c, 6, axis=-1)

    hx = _rms_norm(x, g_pre_mix) * (1 + sc1x) + sh1x
    hc = _rms_norm(ctx, g_pre_mix) * (1 + sc1c) + sh1c
    px = jnp.split(hx @ w_in, SPLIT_POINTS, axis=-1)
    pc = jnp.split(hc @ w_in, SPLIT_POINTS, axis=-1)

    m_x, m_c = _mlstm_bidirectional(_mlstm_prep(px[2], px[3], px[4], px[6], b_gates),
                                    _mlstm_prep(pc[2], pc[3], pc[4], pc[6], b_gates))
    mix_x = jnp.concatenate([
        _conformer_conv(px[0], px[1], conv_a_w, conv_a_b, ln_a_w, ln_a_b, rows),
        _mlstm_out(m_x, px[5], mlstm_norm_w),
        _gated_short_conv(px[7], px[8], px[9], conv_c_w, rows),
    ], axis=-1) @ w_out
    x = x + g1x * _rms_norm(mix_x, g_post_mix)
    hx2 = _rms_norm(x, g_pre_ffn) * (1 + sc2x) + sh2x
    x = x + g2x * _rms_norm(_sq_relu_mlp(hx2, w_ff1, w_ff2), g_post_ffn)

    if update_ctx:
        mix_c = jnp.concatenate([
            _conformer_conv(pc[0], pc[1], conv_a_w, conv_a_b, ln_a_w, ln_a_b, None),
            _mlstm_out(m_c, pc[5], mlstm_norm_w),
            _gated_short_conv(pc[7], pc[8], pc[9], conv_c_w, None),
        ], axis=-1) @ w_out
        ctx = ctx + g1c * _rms_norm(mix_c, g_post_mix)
        hc2 = _rms_norm(ctx, g_pre_ffn) * (1 + sc2c) + sh2c
        ctx = ctx + g2c * _rms_norm(_sq_relu_mlp(hc2, w_ff1, w_ff2), g_post_ffn)
    return x, ctx


def setup_inputs(seed: int = 0) -> dict:
    key = jax.random.key(seed)
    ks = jax.random.split(key, 21)

    def nrm(k, shape, scale):
        return jax.random.normal(k, shape, jnp.float32) * scale

    kg = jax.random.split(ks[11], 4)
    fgate_init = jnp.linspace(3.0, 6.0, MLSTM_HEADS, dtype=jnp.float32)[None, :]
    b_gates = jnp.concatenate([
        nrm(kg[0], (DEPTH, MLSTM_HEADS), 0.1),
        fgate_init + nrm(kg[1], (DEPTH, MLSTM_HEADS), 0.1),
        nrm(kg[2], (DEPTH, MLSTM_HEADS), 0.1),
        fgate_init + nrm(kg[3], (DEPTH, MLSTM_HEADS), 0.1),
    ], axis=-1)
    return {
        "x": nrm(ks[0], (BATCH, SEQ, D_MODEL), 1.0),
        "c": nrm(ks[1], (BATCH, D_MODEL), 1.0),
        "ctx": nrm(ks[2], (BATCH, CTX_LEN, D_MODEL), 1.0),
        "c_ctx": nrm(ks[3], (D_MODEL,), 1.0),
        "w_ada": nrm(ks[4], (DEPTH, D_MODEL, 6 * D_MODEL), 0.5 * D_MODEL ** -0.5),
        "b_ada": nrm(ks[5], (DEPTH, 6 * D_MODEL), 0.02),
        "g_pre_mix": 1.0 + nrm(ks[6], (DEPTH, D_MODEL), 0.02),
        "g_post_mix": 1.0 + nrm(ks[7], (DEPTH, D_MODEL), 0.02),
        "g_pre_ffn": 1.0 + nrm(ks[8], (DEPTH, D_MODEL), 0.02),
        "g_post_ffn": 1.0 + nrm(ks[9], (DEPTH, D_MODEL), 0.02),
        "w_in": nrm(ks[10], (DEPTH, D_MODEL, D_IN), D_MODEL ** -0.5),
        "b_gates": b_gates,
        "conv_a_w": nrm(ks[12], (DEPTH, CONV_A_WIDTH, D_CONV), CONV_A_WIDTH ** -0.5),
        "conv_a_b": nrm(ks[13], (DEPTH, D_CONV), 0.02),
        "ln_a_w": 1.0 + nrm(ks[14], (DEPTH, D_CONV), 0.02),
        "ln_a_b": nrm(ks[15], (DEPTH, D_CONV), 0.02),
        "mlstm_norm_w": 1.0 + nrm(ks[16], (DEPTH, D_MLSTM), 0.02),
        "conv_c_w": nrm(ks[17], (DEPTH, CONV_C_WIDTH, D_SHORT), CONV_C_WIDTH ** -0.5),
        "w_out": nrm(ks[18], (DEPTH, D_MODEL, D_MODEL), D_MODEL ** -0.5),
        "w_ff1": nrm(ks[19], (DEPTH, D_MODEL, D_FF), D_MODEL ** -0.5),
        "w_ff2": nrm(ks[20], (DEPTH, D_FF, D_MODEL), D_FF ** -0.5),
    }


def reference(x, c, ctx, c_ctx, w_ada, b_ada, g_pre_mix, g_post_mix, g_pre_ffn, g_post_ffn,
              w_in, b_gates, conv_a_w, conv_a_b, ln_a_w, ln_a_b, mlstm_norm_w, conv_c_w,
              w_out, w_ff1, w_ff2):
    rows = x.shape[1] // GRID_W
    for layer in range(DEPTH):
        x, ctx = _layer(x, ctx, c, c_ctx, w_ada[layer], b_ada[layer], g_pre_mix[layer],
                        g_post_mix[layer], g_pre_ffn[layer], g_post_ffn[layer], w_in[layer],
                        b_gates[layer], conv_a_w[layer], conv_a_b[layer], ln_a_w[layer],
                        ln_a_b[layer], mlstm_norm_w[layer], conv_c_w[layer], w_out[layer],
                        w_ff1[layer], w_ff2[layer], rows=rows, update_ctx=layer < DEPTH - 1)
    return x
```

```cpp
#include <hip/hip_runtime.h>
#include <hip/hip_cooperative_groups.h>
#include <cstdio>
namespace cg = cooperative_groups;

#ifndef SINGLE_LAUNCH
#define SINGLE_LAUNCH 1
#endif
#ifndef REP_EPI
#define REP_EPI 0
#endif

namespace pg8 {
#define PG8_LAS __attribute__((address_space(3)))
typedef unsigned short bf16_t;
typedef short bf16x8 __attribute__((ext_vector_type(8)));
typedef float f32x4 __attribute__((ext_vector_type(4)));
typedef unsigned u32x4 __attribute__((ext_vector_type(4)));
constexpr int BM = 256, BK = 64, HALF = 128, HTB = HALF * BK * 2  , STAGE_BYTES = 8 * HTB, NXCD = 8, WGM = 8;

__host__ __device__ __forceinline__ int lds_byte(int r, int c) { const int st = (r >> 4) * 2 + (c >> 5), rr = r & 15, cc = c & 31, ob = rr * 64 + cc * 2; return st * 1024 + (ob ^ (((ob >> 9) & 1) << 5)); }
__host__ __device__ __forceinline__ void stage_rc(int b, int& R, int& C) { const int st = b / 1024, sb = b % 1024, swz = sb ^ (((sb >> 9) & 1) << 5); R = (st >> 1) * 16 + swz / 64; C = (st & 1) * 32 + (swz % 64) / 2; }
__host__ __device__ __forceinline__ int perm32(int rho) { const int n = rho >> 4, i = rho & 15; return 8 * (i >> 2) + 4 * n + (i & 3); }

typedef int i32x4 __attribute__((ext_vector_type(4)));
template <bool I8> struct AccT { typedef f32x4 type; };
template <> struct AccT<true> { typedef i32x4 type; };
__device__ __forceinline__ f32x4 mma16(bf16x8 a, bf16x8 b, f32x4 c) { return __builtin_amdgcn_mfma_f32_16x16x32_bf16(a, b, c, 0, 0, 0); }
__device__ __forceinline__ i32x4 mma16(bf16x8 a, bf16x8 b, i32x4 c) { return __builtin_amdgcn_mfma_i32_16x16x64_i8(__builtin_bit_cast(i32x4, a), __builtin_bit_cast(i32x4, b), c, 0, 0, 0); }
struct Unit { int pm, pn, kb, nt, part, lpm, lpn; };
struct Gemm { const bf16_t* A; const bf16_t* Bt; int M, N, K; };
struct StaticOrder {
    int nM, nN, nwg, G, c, ntf, hot = 0;
    __device__ void init(int M, int N, int K, int G_, int c_) { nM = M / BM; nN = N / BM; nwg = nM * nN; G = G_; c = c_; ntf = K / BK; }
    __device__ __forceinline__ void tile(int wgid, int& pm, int& pn) const {
        { const int q = nwg / NXCD, r = nwg % NXCD, xcd = wgid % NXCD, off = wgid / NXCD; wgid = (xcd < r ? xcd * (q + 1) : r * (q + 1) + (xcd - r) * q) + off; }
        const int nig = WGM * nN, gid = wgid / nig, fm = gid * WGM, gsz = (nM - fm) < WGM ? (nM - fm) : WGM;
        pm = fm + ((wgid % nig) % gsz); pn = (wgid % nig) / gsz; }
    __device__ bool next(int i, Unit& u) const {
        const long L = (long)i * G + c; if (L >= nwg) return false;
        int pm, pn; tile((int)L, pm, pn);
        u.pm = pm; u.pn = pn; u.kb = 0; u.nt = ntf; u.part = -1; u.lpm = hot ? 0 : pm; u.lpn = hot ? 0 : pn; return true;
    }
    __device__ __forceinline__ void a_ready(const Unit&) const {}
    __device__ __forceinline__ void done(const Unit&) const {}
};
struct TailSplitOrder {
    StaticOrder base; int nsp, K;
    __device__ void init(int M, int N, int K_, int nsp_, int G_, int c_) { base.init(M, N, K_, G_, c_); nsp = nsp_; K = K_; }
    __device__ bool next(int i, Unit& u) const {
        const long L = (long)i * base.G + base.c; const int s = (int)(L - base.nwg);
        if (L >= base.nwg && s >= nsp * base.nN * 4) return false;
        int pm, pn, kb = 0, nt = base.ntf, part = -1;
        if (L < base.nwg) base.tile((int)L, pm, pn);
        else { const int kq = s & 3, t = s >> 2; pn = t % base.nN; pm = base.nM + t / base.nN; kb = kq * (K / 4) * 2; nt = K / 4 / BK; part = kq; }
        u.pm = pm; u.pn = pn; u.kb = kb; u.nt = nt; u.part = part; u.lpm = pm; u.lpn = pn; return true;
    }
    __device__ __forceinline__ void a_ready(const Unit&) const {}
    __device__ __forceinline__ void done(const Unit&) const {}
};
struct TailTilesOrder {
    StaticOrder base; int ntail, tw, tc0;
    __device__ void init(int M, int N, int K_, int ntail_, int tw_, int tc0_, int G_, int c_) { base.init(M, N, K_, G_, c_); ntail = ntail_; tw = tw_; tc0 = tc0_; }
    __device__ bool next(int i, Unit& u) const {
        const long L = (long)i * base.G + base.c; const int s = (int)(L - base.nwg);
        if (L >= base.nwg && s >= ntail) return false;
        int pm, pn;
        if (L < base.nwg) base.tile((int)L, pm, pn); else { pm = base.nM + s / tw; pn = tc0 + s % tw; }
        u.pm = pm; u.pn = pn; u.kb = 0; u.nt = base.ntf; u.part = -1; u.lpm = pm; u.lpn = pn; return true;
    }
    __device__ __forceinline__ void a_ready(const Unit&) const {}
    __device__ __forceinline__ void done(const Unit&) const {}
};
typedef __bf16 bf16v2_t __attribute__((ext_vector_type(2)));
typedef float f32x2_t __attribute__((ext_vector_type(2)));
__device__ __forceinline__ unsigned cvt_pk_bf16(float lo, float hi) { f32x2_t v = {lo, hi}; bf16v2_t r = __builtin_convertvector(v, bf16v2_t); return __builtin_bit_cast(unsigned, r); }

struct EpiF32 {
    static constexpr bool PERM = false, AFTER_DRAIN = false, I8 = false;
    float* C; int ldc;
    __device__ __forceinline__ void operator()(const f32x4 (&acc)[2][2][4][2], const Unit& u, int wr, int wc, int fr, int fq) const {
        const int row0 = u.pm * BM + wr * 64 + fr, col0 = u.pn * BM + wc * 32 + 4 * fq;
#pragma unroll
        for (int ai = 0; ai < 2; ++ai)
#pragma unroll
            for (int m = 0; m < 4; ++m) { float* rowp = C + (size_t)(row0 + ai * HALF + m * 16) * ldc + col0;
#pragma unroll
                for (int bj = 0; bj < 2; ++bj)
#pragma unroll
                    for (int n = 0; n < 2; ++n) *(f32x4*)(rowp + bj * HALF + n * 16) = acc[ai][bj][m][n]; }
    }
};
template <int ACT> struct EpiBf16 {
    static constexpr bool PERM = true, AFTER_DRAIN = false, I8 = false;
    bf16_t* O; int ldc; float* gates; int gate_pn; bf16_t* QKV; int mt;
    __device__ __forceinline__ void operator()(const f32x4 (&acc)[2][2][4][2], const Unit& u, int wr, int wc, int fr, int fq) const {
        const int row0 = u.pm * BM + wr * 64 + fr;
        const bool gt = (ACT == 0) && (u.pn == gate_pn) && (wc == 0);
        const bool hm = (ACT == 0) && (u.pn >= 4) && (u.pn < 16);
        bf16_t* base; size_t rstride, bstride;
        if (hm) { base = QKV + ((size_t)((u.pn - 4) * 2) * mt + row0) * 128 + wc * 32 + 8 * fq; rstride = 128; bstride = (size_t)mt * 128; }
        else { const int colt = (ACT == 0) ? ((u.pn < 4 ? u.pn : u.pn - 12) * BM) : u.pn * BM; base = O + (size_t)row0 * ldc + colt + wc * 32 + 8 * fq; rstride = (size_t)ldc; bstride = HALF; }
#pragma unroll
        for (int ai = 0; ai < 2; ++ai)
#pragma unroll
            for (int m = 0; m < 4; ++m) { bf16_t* rowp = base + (size_t)(ai * HALF + m * 16) * rstride;
#pragma unroll
                for (int bj = 0; bj < 2; ++bj) { f32x4 v0 = acc[ai][bj][m][0], v1 = acc[ai][bj][m][1];
                    if (ACT == 1) {
#pragma unroll
                        for (int j = 0; j < 4; ++j) { float a0 = fmaxf(v0[j], 0.f), a1 = fmaxf(v1[j], 0.f); v0[j] = a0 * a0; v1[j] = a1 * a1; } }
                    if (ACT == 0 && bj == 0 && gt) { float* gp = gates + (size_t)(row0 + ai * HALF + m * 16) * 32 + 8 * fq; *(f32x4*)gp = v0; *(f32x4*)(gp + 4) = v1; }
                    u32x4 w; w.x = cvt_pk_bf16(v0[0], v0[1]); w.y = cvt_pk_bf16(v0[2], v0[3]); w.z = cvt_pk_bf16(v1[0], v1[1]); w.w = cvt_pk_bf16(v1[2], v1[3]);
                    *(u32x4*)(rowp + bj * bstride) = w; } }
    }
};
struct EpiY {
    static constexpr bool PERM = true, AFTER_DRAIN = false, I8 = false;
    bf16_t* O; int ldc; float* P; int row0; size_t pstride;
    __device__ __forceinline__ void operator()(const f32x4 (&acc)[2][2][4][2], const Unit& u, int wr, int wc, int fr, int fq) const {
        const int row0_ = u.pm * BM + wr * 64 + fr, col0 = u.pn * BM + wc * 32 + 8 * fq;
        if (u.part < 0) {
#pragma unroll
            for (int ai = 0; ai < 2; ++ai)
#pragma unroll
                for (int m = 0; m < 4; ++m) { bf16_t* rowp = O + (size_t)(row0_ + ai * HALF + m * 16) * ldc + col0;
#pragma unroll
                    for (int bj = 0; bj < 2; ++bj) { const f32x4 v0 = acc[ai][bj][m][0], v1 = acc[ai][bj][m][1];
                        u32x4 w; w.x = cvt_pk_bf16(v0[0], v0[1]); w.y = cvt_pk_bf16(v0[2], v0[3]); w.z = cvt_pk_bf16(v1[0], v1[1]); w.w = cvt_pk_bf16(v1[2], v1[3]);
                        *(u32x4*)(rowp + bj * HALF) = w; } }
        } else {
            float* base = P + (size_t)u.part * pstride;
#pragma unroll
            for (int ai = 0; ai < 2; ++ai)
#pragma unroll
                for (int m = 0; m < 4; ++m) { float* rowp = base + (size_t)(row0_ - row0 + ai * HALF + m * 16) * ldc + col0;
#pragma unroll
                    for (int bj = 0; bj < 2; ++bj) { *(f32x4*)(rowp + bj * HALF) = acc[ai][bj][m][0]; *(f32x4*)(rowp + bj * HALF + 4) = acc[ai][bj][m][1]; } }
        }
    }
};
struct EpiProjI8 {
    static constexpr bool PERM = true, AFTER_DRAIN = false, I8 = true;
    bf16_t* O; int ldc; float* gates; int gate_pn; bf16_t* QKV; int mt; const float* rs; const float* cs;
    __device__ __forceinline__ void operator()(const i32x4 (&acc)[2][2][4][2], const Unit& u, int wr, int wc, int fr, int fq) const {
        const int row0 = u.pm * BM + wr * 64 + fr;
        const bool gt = (u.pn == gate_pn) && (wc == 0);
        const bool hm = (u.pn >= 4) && (u.pn < 16);
        bf16_t* base; size_t rstride, bstride;
        if (hm) { base = QKV + ((size_t)((u.pn - 4) * 2) * mt + row0) * 128 + wc * 32 + 8 * fq; rstride = 128; bstride = (size_t)mt * 128; }
        else { const int colt = (u.pn < 4 ? u.pn : u.pn - 12) * BM; base = O + (size_t)row0 * ldc + colt + wc * 32 + 8 * fq; rstride = (size_t)ldc; bstride = HALF; }
        f32x4 cv[2][2];
#pragma unroll
        for (int bj = 0; bj < 2; ++bj)
#pragma unroll
            for (int n = 0; n < 2; ++n) cv[bj][n] = *(const f32x4*)(cs + u.pn * BM + bj * HALF + wc * 32 + 8 * fq + 4 * n);
#pragma unroll
        for (int ai = 0; ai < 2; ++ai)
#pragma unroll
            for (int m = 0; m < 4; ++m) { const int row = row0 + ai * HALF + m * 16; bf16_t* rowp = base + (size_t)(ai * HALF + m * 16) * rstride; const float r = rs[row];
#pragma unroll
                for (int bj = 0; bj < 2; ++bj) { const i32x4 a0 = acc[ai][bj][m][0], a1 = acc[ai][bj][m][1];
                    const f32x4 v0 = (f32x4){(float)a0[0], (float)a0[1], (float)a0[2], (float)a0[3]} * cv[bj][0] * r, v1 = (f32x4){(float)a1[0], (float)a1[1], (float)a1[2], (float)a1[3]} * cv[bj][1] * r;
                    if (bj == 0 && gt) { float* gp = gates + (size_t)row * 32 + 8 * fq; *(f32x4*)gp = v0; *(f32x4*)(gp + 4) = v1; }
                    u32x4 w; w.x = cvt_pk_bf16(v0[0], v0[1]); w.y = cvt_pk_bf16(v0[2], v0[3]); w.z = cvt_pk_bf16(v1[0], v1[1]); w.w = cvt_pk_bf16(v1[2], v1[3]);
                    *(u32x4*)(rowp + bj * bstride) = w; } }
    }
};
struct EpiSqReluI8 {
    static constexpr bool PERM = true, AFTER_DRAIN = false, I8 = true;
    bf16_t* O; int ldc; const float* rs; const float* cs;
    __device__ __forceinline__ void operator()(const i32x4 (&acc)[2][2][4][2], const Unit& u, int wr, int wc, int fr, int fq) const {
        const int row0 = u.pm * BM + wr * 64 + fr, col0 = u.pn * BM + wc * 32 + 8 * fq;
        f32x4 cv[2][2];
#pragma unroll
        for (int bj = 0; bj < 2; ++bj)
#pragma unroll
            for (int n = 0; n < 2; ++n) cv[bj][n] = *(const f32x4*)(cs + col0 + bj * HALF + 4 * n);
#pragma unroll
        for (int ai = 0; ai < 2; ++ai)
#pragma unroll
            for (int m = 0; m < 4; ++m) { const int row = row0 + ai * HALF + m * 16; bf16_t* rowp = O + (size_t)row * ldc + col0; const float r = rs[row];
#pragma unroll
                for (int bj = 0; bj < 2; ++bj) { const i32x4 a0 = acc[ai][bj][m][0], a1 = acc[ai][bj][m][1];
                    f32x4 v0 = (f32x4){(float)a0[0], (float)a0[1], (float)a0[2], (float)a0[3]} * cv[bj][0] * r, v1 = (f32x4){(float)a1[0], (float)a1[1], (float)a1[2], (float)a1[3]} * cv[bj][1] * r;
#pragma unroll
                    for (int j = 0; j < 4; ++j) { const float b0 = fmaxf(v0[j], 0.f), b1 = fmaxf(v1[j], 0.f); v0[j] = b0 * b0; v1[j] = b1 * b1; }
                    u32x4 w; w.x = cvt_pk_bf16(v0[0], v0[1]); w.y = cvt_pk_bf16(v0[2], v0[3]); w.z = cvt_pk_bf16(v1[0], v1[1]); w.w = cvt_pk_bf16(v1[2], v1[3]);
                    *(u32x4*)(rowp + bj * HALF) = w; } }
    }
};

template <class Epi, class Sched, bool ALIGN_EPI = true, bool SP2 = true>
__device__ __forceinline__ void gemm_phase(PG8_LAS unsigned char* lds, const Gemm g, const Sched& S, const Epi& E) {
    int tid = threadIdx.x; asm volatile("" : "+v"(tid));
    const int wid = __builtin_amdgcn_readfirstlane(tid >> 6), lane = tid & 63, wr = wid >> 2, wc = wid & 3, fr = lane & 15, fq = lane >> 4;
    const int K = g.K;
    unsigned voffA[2], voffB[2];
#pragma unroll
    for (int i = 0; i < 2; ++i) { int R, C; stage_rc(tid * 16 + i * 8192, R, C); const int Rb = Epi::PERM ? ((R & ~31) + perm32(R & 31)) : R;
        voffA[i] = (unsigned)(R * K + C) * 2u; voffB[i] = (unsigned)(Rb * K + C) * 2u; }
    const size_t kstep = (size_t)(BK * 2);
    const size_t hstep = (size_t)HALF * K * 2;
    const size_t tstep = 2 * hstep;
    const unsigned ldsw = (unsigned)wid * 1024u;
    const int aoff = lds_byte(wr * 64 + fr, fq * 8), boff = lds_byte(wc * 32 + fr, fq * 8);
#define PG8_SA(b, h) (((b) * 2 + (h)) * HTB)
#define PG8_SB(b, h) ((4 + (b) * 2 + (h)) * HTB)
#define PG8_STAGE(bufoff, gbase, voff) do { _Pragma("unroll") for (int _i = 0; _i < 2; ++_i) \
        __builtin_amdgcn_global_load_lds((const unsigned*)((const char*)(gbase) + (voff)[_i]), (PG8_LAS unsigned*)(lds + (bufoff) + ldsw + _i * 8192), 16, 0, 0); } while (0)
#define PG8_LDA(dst, b, h) do { _Pragma("unroll") for (int m = 0; m < 4; ++m) _Pragma("unroll") for (int k = 0; k < 2; ++k) dst[m][k] = *(const PG8_LAS bf16x8*)(lds + PG8_SA(b, h) + aoff + m * 2048 + k * 1024); } while (0)
#define PG8_LDB(dst, b, h) do { _Pragma("unroll") for (int n = 0; n < 2; ++n) _Pragma("unroll") for (int k = 0; k < 2; ++k) dst[n][k] = *(const PG8_LAS bf16x8*)(lds + PG8_SB(b, h) + boff + n * 2048 + k * 1024); } while (0)
#define PG8_MMA(ai, bj, At, Bt) do { __builtin_amdgcn_s_setprio(1); _Pragma("unroll") for (int m = 0; m < 4; ++m) _Pragma("unroll") for (int n = 0; n < 2; ++n) _Pragma("unroll") for (int k = 0; k < 2; ++k) \
        acc[ai][bj][m][n] = mma16(Bt[n][k], At[m][k], acc[ai][bj][m][n]); __builtin_amdgcn_s_setprio(0); } while (0)
#define PG8_WAIT_V(n) asm volatile("s_waitcnt vmcnt(" #n ")" ::: "memory")
#define PG8_WAIT_L(n) asm volatile("s_waitcnt lgkmcnt(" #n ")" ::: "memory")
#define PG8_BAR __builtin_amdgcn_s_barrier()
#define PG8_SCHED __builtin_amdgcn_sched_barrier(0)
    Unit cur, nxt; int ui = 0;
    if (!S.next(0, cur)) return;
    typedef typename AccT<Epi::I8>::type acc_t;
    acc_t acc[2][2][4][2];
#pragma unroll
    for (int a = 0; a < 2; ++a)
#pragma unroll
        for (int b = 0; b < 2; ++b)
#pragma unroll
            for (int m = 0; m < 4; ++m)
#pragma unroll
                for (int n = 0; n < 2; ++n) acc[a][b][m][n] = (acc_t){0, 0, 0, 0};
    bf16x8 At[4][2], B0[2][2], B1[2][2];
    const char* cA = (const char*)g.A + (size_t)cur.lpm * tstep + cur.kb; const char* cB = (const char*)g.Bt + (size_t)cur.lpn * tstep + cur.kb;
    S.a_ready(cur);
    if constexpr (SP2) {
        PG8_STAGE(PG8_SB(0, 0), cB, voffB); PG8_STAGE(PG8_SB(0, 1), cB + hstep, voffB); PG8_STAGE(PG8_SA(0, 0), cA, voffA); PG8_STAGE(PG8_SA(0, 1), cA + hstep, voffA);
        if (wr == 1) PG8_BAR;
        PG8_WAIT_V(2); PG8_BAR;
        PG8_STAGE(PG8_SB(1, 0), cB + kstep, voffB); PG8_STAGE(PG8_SA(1, 0), cA + kstep, voffA); PG8_STAGE(PG8_SB(1, 1), cB + hstep + kstep, voffB);
        PG8_WAIT_V(6); PG8_BAR;
    } else {
        PG8_STAGE(PG8_SB(0, 0), cB, voffB); PG8_STAGE(PG8_SA(0, 0), cA, voffA); PG8_STAGE(PG8_SB(0, 1), cB + hstep, voffB); PG8_STAGE(PG8_SA(0, 1), cA + hstep, voffA);
        if (wr == 1) PG8_BAR;
        PG8_WAIT_V(4); PG8_BAR;
        PG8_STAGE(PG8_SB(1, 0), cB + kstep, voffB); PG8_STAGE(PG8_SA(1, 0), cA + kstep, voffA); PG8_STAGE(PG8_SB(1, 1), cB + hstep + kstep, voffB);
        PG8_WAIT_V(6); PG8_BAR;
    }
    for (;;) {
        const bool has_next = S.next(ui + 1, nxt);
        const char* nA = has_next ? (const char*)g.A + (size_t)nxt.lpm * tstep + nxt.kb : cA; const char* nB = has_next ? (const char*)g.Bt + (size_t)nxt.lpn * tstep + nxt.kb : cB;
        const int nt = cur.nt;
        for (int t = 0; t < nt; t += 2) {
            const bool last = (t == nt - 2);
            const char* a1 = cA + (size_t)(t + 1) * kstep;
            const char* a2 = last ? nA : cA + (size_t)(t + 2) * kstep; const char* b2 = last ? nB : cB + (size_t)(t + 2) * kstep;
            const char* a3 = a2 + kstep; const char* b3 = b2 + kstep;
            if (last && has_next) S.a_ready(nxt);
            if constexpr (SP2) {
            PG8_LDB(B0, 0, 0); PG8_LDB(B1, 0, 1); PG8_SCHED; PG8_LDA(At, 0, 0); PG8_STAGE(PG8_SA(1, 1), a1 + hstep, voffA);
            PG8_WAIT_V(8); PG8_WAIT_L(0); PG8_BAR; PG8_MMA(0, 0, At, B0); PG8_MMA(0, 1, At, B1); PG8_BAR; PG8_SCHED;
            PG8_LDA(At, 0, 1); PG8_STAGE(PG8_SB(0, 0), b2, voffB); PG8_STAGE(PG8_SB(0, 1), b2 + hstep, voffB); PG8_STAGE(PG8_SA(0, 0), a2, voffA);
            PG8_WAIT_V(8); PG8_WAIT_L(0); PG8_BAR; PG8_MMA(1, 0, At, B0); PG8_MMA(1, 1, At, B1); PG8_BAR; PG8_SCHED;
            PG8_LDB(B0, 1, 0); PG8_LDB(B1, 1, 1); PG8_SCHED; PG8_LDA(At, 1, 0); PG8_STAGE(PG8_SA(0, 1), a2 + hstep, voffA);
            PG8_WAIT_V(8); PG8_WAIT_L(0); PG8_BAR; PG8_MMA(0, 0, At, B0); PG8_MMA(0, 1, At, B1); PG8_BAR; PG8_SCHED;
            PG8_LDA(At, 1, 1); PG8_STAGE(PG8_SB(1, 0), b3, voffB); PG8_STAGE(PG8_SB(1, 1), b3 + hstep, voffB); PG8_STAGE(PG8_SA(1, 0), a3, voffA);
            PG8_WAIT_V(8); PG8_WAIT_L(0); PG8_BAR; PG8_MMA(1, 0, At, B0); PG8_MMA(1, 1, At, B1); PG8_BAR; PG8_SCHED;
            } else {
            PG8_LDB(B0, 0, 0); PG8_SCHED; PG8_LDA(At, 0, 0); PG8_STAGE(PG8_SA(1, 1), a1 + hstep, voffA);
            PG8_WAIT_L(8); PG8_BAR; PG8_WAIT_L(0); PG8_MMA(0, 0, At, B0); PG8_BAR; PG8_SCHED;
            PG8_LDB(B1, 0, 1); PG8_STAGE(PG8_SB(0, 0), b2, voffB);
            PG8_BAR; PG8_WAIT_L(0); PG8_MMA(0, 1, At, B1); PG8_BAR;
            PG8_LDA(At, 0, 1); PG8_STAGE(PG8_SA(0, 0), a2, voffA);
            PG8_BAR; PG8_WAIT_L(0); PG8_MMA(1, 0, At, B0); PG8_BAR; PG8_SCHED;
            PG8_STAGE(PG8_SB(0, 1), b2 + hstep, voffB);
            PG8_WAIT_V(6); PG8_BAR; PG8_MMA(1, 1, At, B1); PG8_BAR;
            PG8_LDB(B0, 1, 0); PG8_SCHED; PG8_LDA(At, 1, 0); PG8_STAGE(PG8_SA(0, 1), a2 + hstep, voffA);
            PG8_WAIT_L(8); PG8_BAR; PG8_WAIT_L(0); PG8_MMA(0, 0, At, B0); PG8_BAR; PG8_SCHED;
            PG8_LDB(B1, 1, 1); PG8_STAGE(PG8_SB(1, 0), b3, voffB);
            PG8_BAR; PG8_WAIT_L(0); PG8_MMA(0, 1, At, B1); PG8_BAR;
            PG8_LDA(At, 1, 1); PG8_STAGE(PG8_SA(1, 0), a3, voffA);
            PG8_BAR; PG8_WAIT_L(0); PG8_MMA(1, 0, At, B0); PG8_BAR; PG8_SCHED;
            PG8_STAGE(PG8_SB(1, 1), b3 + hstep, voffB);
            PG8_WAIT_V(6); PG8_BAR; PG8_MMA(1, 1, At, B1); PG8_BAR;
            }
        }
        if constexpr (ALIGN_EPI) { if (wr == 0) PG8_BAR; }
        if constexpr (!Epi::AFTER_DRAIN) { for (int re_ = 0; re_ <= REP_EPI; ++re_) E(acc, cur, wr, wc, fr, fq); S.done(cur); }
        if (!has_next) break;
#pragma unroll
        for (int a = 0; a < 2; ++a)
#pragma unroll
            for (int b = 0; b < 2; ++b)
#pragma unroll
                for (int m = 0; m < 4; ++m)
#pragma unroll
                    for (int n = 0; n < 2; ++n) acc[a][b][m][n] = (acc_t){0, 0, 0, 0};
        cur = nxt; cA = nA; cB = nB; ++ui;
        if constexpr (ALIGN_EPI) { if (wr == 1) PG8_BAR; }
    }
    PG8_WAIT_V(0);
    if constexpr (!ALIGN_EPI) { if (wr == 0) PG8_BAR; }
    PG8_BAR;
    if constexpr (Epi::AFTER_DRAIN) { E.fused(acc, cur, wr, wc, fr, fq, lds, wid, lane); S.done(cur); }
#undef PG8_SA
#undef PG8_SB
#undef PG8_STAGE
#undef PG8_LDA
#undef PG8_LDB
#undef PG8_MMA
#undef PG8_WAIT_V
#undef PG8_WAIT_L
#undef PG8_BAR
#undef PG8_SCHED
}
}
using pg8::bf16_t; using pg8::bf16x8; using pg8::f32x4; using pg8::u32x4;
#define LAS __attribute__((address_space(3)))
typedef short s16x4 __attribute__((ext_vector_type(4)));
typedef unsigned u32x2 __attribute__((ext_vector_type(2)));

constexpr int D = 2048, NB = 8, SEQ = 2048, DEPTH = 2, CTXL = 256, DCONV = 512, DML = 1024, NH = 8, DH = 128, KA = 31, DFF = 8192;
constexpr int DIN = 6688, DINP = 6912, MX = NB * SEQ, MC = NB * CTXL, MT = MX + MC;
constexpr int C_AVAL = 0, C_AGATE = 512, C_Q = 1024, C_K = 2048, C_V = 3072, C_O = 4096, C_G = 5120, C_SIN = 5152, C_SB = 5664, C_SC = 6176;
constexpr int DP = DINP - 3 * DML, P_AVAL = 0, P_AGATE = 512, P_O = C_O - 3 * DML, P_SIN = C_SIN - 3 * DML, P_SB = C_SB - 3 * DML, P_SC = C_SC - 3 * DML;
constexpr float EPS = 1e-6f;
constexpr int LDS_BYTES = 131072 + 16, LDS_BARST = 131072;
constexpr size_t SZ_WIN = (size_t)DINP * D * 2, SZ_WOUT = (size_t)D * D * 2, SZ_WFF = (size_t)DFF * D * 2, SZ_WL = SZ_WIN + SZ_WOUT + 2 * SZ_WFF;
constexpr size_t WS_W = 0, WS_XB = WS_W + SZ_WL, WS_HX = WS_XB + (size_t)MT * D * 2, WS_PROJ = WS_HX + (size_t)MT * D * 2, WS_QKVH = WS_PROJ + (size_t)MT * DP * 2, WS_MIX = WS_PROJ + (size_t)MT * DINP * 2,
                 WS_Y = WS_MIX + (size_t)MT * D * 2, WS_YP = WS_Y + (size_t)MT * D * 2, WS_GATES = WS_Y + (size_t)MT * D * 4, WS_CTX = WS_GATES + (size_t)MT * 32 * 4,
                 WS_MOD = WS_CTX + (size_t)MC * D * 4, WS_BAR = WS_MOD + (size_t)DEPTH * 9 * 6 * D * 4, WS_CMAX = WS_BAR + 16384, WS_CSC = WS_CMAX + (size_t)DEPTH * DFF * 4, WS_RSC = WS_CSC + (size_t)DEPTH * DFF * 4, WS_END = WS_RSC + (size_t)MT * 4;
static_assert((size_t)MT * DFF * 2 <= WS_Y - WS_PROJ, "H1 aliases PROJ+MIX");

struct Args { const float* in[21]; float* out; unsigned char* ws; int ph_lo, ph_hi; };
enum { I_X = 0, I_C, I_CTX, I_CCTX, I_WADA, I_BADA, I_GPREMIX, I_GPOSTMIX, I_GPREFFN, I_GPOSTFFN, I_WIN, I_BGATES, I_CAW, I_CAB, I_LNAW, I_LNAB, I_MNW, I_CCW, I_WOUT, I_WFF1, I_WFF2 };

__device__ __forceinline__ int otid() { int t = threadIdx.x; asm volatile("" : "+v"(t)); return t; }
__device__ __forceinline__ float wave_sum(float v) {
#pragma unroll
    for (int o = 32; o; o >>= 1) v += __shfl_xor(v, o);
    return v; }
__device__ __forceinline__ float bf2f(unsigned short h) { return __uint_as_float(((unsigned)h) << 16); }
__device__ __forceinline__ float bflo(unsigned w) { return __uint_as_float(w << 16); }
__device__ __forceinline__ float bfhi(unsigned w) { return __uint_as_float(w & 0xffff0000u); }
__device__ __forceinline__ unsigned short f2bf(float f) { return (unsigned short)(pg8::cvt_pk_bf16(f, 0.f) & 0xffffu); }
__device__ __forceinline__ float sigmoidf_(float x) { return __builtin_amdgcn_rcpf(1.f + __expf(-x)); }

#define XB_TMO      128
#define XB_XCNT(j)  (256  + 64 * (j))
#define XB_XSUB(j)  (1280 + 64 * (j))
#define XB_XGEN(j)  (2304 + 64 * (j))
#define XB_TOP      3328
#define XB_TOPGEN   3392
#define XCD_BAR_WORDS 3456
#define XB_SPIN_CAP (1u << 18)

__device__ __forceinline__ unsigned xb_ld(unsigned* p)              { return __hip_atomic_load(p, __ATOMIC_RELAXED, __HIP_MEMORY_SCOPE_AGENT); }
__device__ __forceinline__ unsigned xb_add(unsigned* p, unsigned v) { return __hip_atomic_fetch_add(p, v, __ATOMIC_RELAXED, __HIP_MEMORY_SCOPE_AGENT); }
__device__ __forceinline__ unsigned xb_xcc_id() { return (unsigned)__builtin_amdgcn_s_getreg((3 << 11) | 20) & 0xFu; }
#define XB_SPIN(cond, bar) do { unsigned _sp = 0; while (cond) { __builtin_amdgcn_s_sleep(1); \
    if ((++_sp & 255u) == 0u) { if (xb_ld(&(bar)[XB_TMO])) break; if (_sp > XB_SPIN_CAP) { atomicAdd(&(bar)[XB_TMO], 1u); break; } } } } while (0)

struct XcdBarrier {
    unsigned* bar; unsigned x;
    volatile LAS unsigned* st;
};

__device__ __forceinline__ XcdBarrier xcd_barrier_post(unsigned* bar, volatile LAS unsigned* st) {
    XcdBarrier b; b.bar = bar; b.x = xb_xcc_id(); b.st = st;
    if (threadIdx.x == 0) (void)xb_add(&bar[XB_XCNT(b.x)], 1u);
    return b;
}
__device__ __forceinline__ void xcd_barrier_complete(unsigned* bar, unsigned x, unsigned& nloc, unsigned& nx) {
    const unsigned G = gridDim.x * gridDim.y * gridDim.z;
    unsigned sum, cnt, mine, sp = 0u;
    for (;;) {
        sum = 0u; cnt = 0u; mine = 0u;
#pragma unroll
        for (unsigned j = 0; j < 16; ++j) { const unsigned c = xb_ld(&bar[XB_XCNT(j)]); sum += c; cnt += (c > 0u) ? 1u : 0u; mine = (j == x) ? c : mine; }
        if (sum == G) break;
        __builtin_amdgcn_s_sleep(1);
        if ((++sp & 255u) == 0u) { if (xb_ld(&bar[XB_TMO])) break; if (sp > XB_SPIN_CAP) { atomicAdd(&bar[XB_TMO], 1u); break; } }
    }
    nloc = mine > 0u ? mine : 1u; nx = cnt > 0u ? cnt : 1u;
}

__device__ __forceinline__ void xcd_barrier(const XcdBarrier& b) {
    asm volatile("s_waitcnt vmcnt(0)" ::: "memory");
    __syncthreads();
    if (threadIdx.x == 0) {
        unsigned* bar; { const unsigned long long bp_ = (unsigned long long)b.bar; unsigned lo_ = __builtin_amdgcn_readfirstlane((unsigned)bp_), hi_ = __builtin_amdgcn_readfirstlane((unsigned)(bp_ >> 32)); asm volatile("" : "+s"(lo_), "+s"(hi_)); bar = (unsigned*)(((unsigned long long)hi_ << 32) | lo_); } unsigned bx = __builtin_amdgcn_readfirstlane(b.x); asm volatile("" : "+s"(bx));
        __builtin_amdgcn_s_waitcnt(0);
        unsigned nloc = b.st[0], nx = b.st[1];
        if (nloc == 0u) { xcd_barrier_complete(bar, bx, nloc, nx); b.st[0] = nloc; b.st[1] = nx; }
        const unsigned old = xb_add(&bar[XB_XSUB(bx)], 1u);
        const unsigned gen = old / nloc;
        if (old + 1u == (gen + 1u) * nloc) {
            __builtin_amdgcn_fence(__ATOMIC_RELEASE, "agent");
            asm volatile("s_waitcnt vmcnt(0)" ::: "memory");
            const unsigned og = xb_add(&bar[XB_TOP], 1u);
            const unsigned tg = og / nx;
            if (og + 1u == (tg + 1u) * nx) xb_add(&bar[XB_TOPGEN], 1u);
            else XB_SPIN(xb_ld(&bar[XB_TOPGEN]) == tg, bar);
            __builtin_amdgcn_fence(__ATOMIC_ACQUIRE, "agent");
            xb_add(&bar[XB_XGEN(bx)], 1u);
            asm volatile("s_waitcnt vmcnt(0)" ::: "memory");
        } else {
            XB_SPIN(xb_ld(&bar[XB_XGEN(bx)]) == gen, bar);
            __builtin_amdgcn_fence(__ATOMIC_ACQUIRE, "agent");
            asm volatile("s_waitcnt vmcnt(0)" ::: "memory");
        }
    }
    __syncthreads();
}


#define LDS_BARRIER() do { asm volatile("s_waitcnt lgkmcnt(0)" ::: "memory"); __builtin_amdgcn_s_barrier(); asm volatile("" ::: "memory"); } while (0)
__device__ void convert_matrix(const float* __restrict__ W, int K, int N, int Npad, bf16_t* __restrict__ Wt, int klo, int khi, LAS float* t, const float* cmax, float* csc) {
    constexpr int CVT = 4;
    const int tid = otid(), ntk = K / 64, ntn = Npad / 64, ntiles = ntk * ntn, G = gridDim.x;
    const int kr0 = tid >> 4, c4 = tid & 15;
    f32x4 cur[CVT][2], nx[CVT][2];
#define CV_LOAD(dst, it_) do { _Pragma("unroll") for (int p_ = 0; p_ < CVT; ++p_) { const int itp_ = (it_) + p_ * G; const int tk_ = itp_ / ntn, tn_ = itp_ % ntn, n_ = tn_ * 64 + c4 * 4; \
        _Pragma("unroll") for (int i_ = 0; i_ < 2; ++i_) { dst[p_][i_] = (f32x4){0.f, 0.f, 0.f, 0.f}; \
            if (itp_ < ntiles && n_ < N) dst[p_][i_] = *(const f32x4*)(W + (size_t)(tk_ * 64 + kr0 + 32 * i_) * N + n_); } } } while (0)
    int it = blockIdx.x;
    if (it < ntiles) CV_LOAD(cur, it);
    for (; it < ntiles; it += CVT * G) {
        if (it + CVT * G < ntiles) CV_LOAD(nx, it + CVT * G);
#pragma unroll
        for (int p = 0; p < CVT; ++p)
#pragma unroll
            for (int i = 0; i < 2; ++i) { LAS float* tp = t + p * 64 * 65 + (kr0 + 32 * i) * 65 + c4 * 4; tp[0] = cur[p][i][0]; tp[1] = cur[p][i][1]; tp[2] = cur[p][i][2]; tp[3] = cur[p][i][3]; }
        LDS_BARRIER();
#pragma unroll
        for (int p = 0; p < CVT; ++p) { const int itp = it + p * G;
            if (itp < ntiles) { const int tk = itp / ntn, tn = itp % ntn, nl = tid >> 3, ks = (tid & 7) * 8, n = tn * 64 + nl; const float sc = (n >= klo && n < khi) ? 0.08838834764831845f : 1.f;
                float v[8];
                if (cmax) {
                    const float cm = cmax[n], inv = cm > 0.f ? 127.f / cm : 0.f;
#pragma unroll
                    for (int i = 0; i < 8; ++i) v[i] = t[p * 64 * 65 + (ks + i) * 65 + nl] * inv;
                    unsigned q[8];
#pragma unroll
                    for (int i = 0; i < 8; ++i) q[i] = (unsigned)(int)__builtin_rintf(v[i]) & 0xffu;
                    u32x2 w; w.x = q[0] | (q[1] << 8) | (q[2] << 16) | (q[3] << 24); w.y = q[4] | (q[5] << 8) | (q[6] << 16) | (q[7] << 24);
                    *(u32x2*)((unsigned char*)Wt + (size_t)n * K + tk * 64 + ks) = w;
                    if (tk == 0 && ks == 0) csc[n] = cm * (1.f / 127.f) * sc;
                } else {
#pragma unroll
                for (int i = 0; i < 8; ++i) v[i] = t[p * 64 * 65 + (ks + i) * 65 + nl] * sc;
                u32x4 w; w.x = pg8::cvt_pk_bf16(v[0], v[1]); w.y = pg8::cvt_pk_bf16(v[2], v[3]); w.z = pg8::cvt_pk_bf16(v[4], v[5]); w.w = pg8::cvt_pk_bf16(v[6], v[7]);
                *(u32x4*)(Wt + (size_t)n * K + tk * 64 + ks) = w; } } }
        LDS_BARRIER();
#pragma unroll
        for (int p = 0; p < CVT; ++p)
#pragma unroll
            for (int i = 0; i < 2; ++i) cur[p][i] = nx[p][i];
    }
#undef CV_LOAD
    __syncthreads();
}
__device__ void colmax_phase(const Args& a, LAS float* red) {
    const int tid = otid(), lane = tid & 63, wv = tid >> 6, cgp = tid & 15, kq = tid >> 4;
    float* CM = (float*)(a.ws + WS_CMAX);
    for (int item = blockIdx.x; item < DEPTH * (DFF / 64); item += gridDim.x) {
        const int layer = item / (DFF / 64), n0 = (item % (DFF / 64)) * 64; const float* W = a.in[I_WFF1] + (size_t)layer * D * DFF + n0 + cgp * 4;
        f32x4 mx = (f32x4){0.f, 0.f, 0.f, 0.f};
#pragma unroll 8
        for (int kk = 0; kk < 64; ++kk) { const f32x4 w = *(const f32x4*)(W + (size_t)(kq * 64 + kk) * DFF); mx = __builtin_elementwise_max(mx, __builtin_elementwise_abs(w)); }
#pragma unroll
        for (int j = 0; j < 4; ++j) { float v = mx[j]; v = fmaxf(v, __shfl_xor(v, 16)); v = fmaxf(v, __shfl_xor(v, 32)); mx[j] = v; }
        if (lane < 16) {
#pragma unroll
            for (int j = 0; j < 4; ++j) red[wv * 64 + cgp * 4 + j] = mx[j]; }
        LDS_BARRIER();
        if (tid < 64) { float v = 0.f;
#pragma unroll
            for (int w8 = 0; w8 < 8; ++w8) v = fmaxf(v, red[w8 * 64 + tid]);
            CM[(size_t)layer * DFF + n0 + tid] = v; }
        LDS_BARRIER();
    }
    __syncthreads();
}
__device__ void mods_phase(const Args& a, LAS float* lds) {
    const int tid = otid(), lane = tid & 63, wv = tid >> 6;
    LAS float* sl = lds;
    LAS float* red = lds + 9 * D;
    for (int i = tid; i < 9 * D; i += 512) { const int r = i >> 11, k = i & (D - 1); const float c = r < 8 ? a.in[I_C][r * D + k] : a.in[I_CCTX][k]; sl[i] = c / (1.f + __expf(-c)); }
    __syncthreads();
    float* MOD = (float*)(a.ws + WS_MOD);
    const int cgp = tid & 15, kq = tid >> 4;
    for (int item = blockIdx.x; item < DEPTH * 192; item += gridDim.x) {
        const int layer = item / 192, n0 = (item % 192) * 64;
        const float* W = a.in[I_WADA] + (size_t)layer * D * 6 * D + n0 + cgp * 4;
        f32x4 acc[9];
#pragma unroll
        for (int r = 0; r < 9; ++r) acc[r] = (f32x4){0.f, 0.f, 0.f, 0.f};
#pragma unroll 2
        for (int kk = 0; kk < 64; kk += 4) { const int k = kq * 64 + kk; f32x4 w[4];
#pragma unroll
            for (int j = 0; j < 4; ++j) w[j] = *(const f32x4*)(W + (size_t)(k + j) * 6 * D);
#pragma unroll
            for (int r = 0; r < 9; ++r) { const f32x4 s = *(const LAS f32x4*)(sl + r * D + k); acc[r] += w[0] * s[0]; acc[r] += w[1] * s[1]; acc[r] += w[2] * s[2]; acc[r] += w[3] * s[3]; } }
#pragma unroll
        for (int r = 0; r < 9; ++r)
#pragma unroll
            for (int j = 0; j < 4; ++j) { float v = acc[r][j]; v += __shfl_xor(v, 16); v += __shfl_xor(v, 32); acc[r][j] = v; }
        if (lane < 16) {
#pragma unroll
            for (int r = 0; r < 9; ++r)
#pragma unroll
                for (int j = 0; j < 4; ++j) red[(wv * 9 + r) * 64 + cgp * 4 + j] = acc[r][j]; }
        LDS_BARRIER();
        for (int o = tid; o < 9 * 64; o += 512) { const int r = o >> 6, c = o & 63; float s = a.in[I_BADA][layer * 6 * D + n0 + c];
#pragma unroll
            for (int w8 = 0; w8 < 8; ++w8) s += red[(w8 * 9 + r) * 64 + c];
            MOD[((size_t)layer * 9 + r) * 6 * D + n0 + c] = s; }
        LDS_BARRIER();
    }
}

template <int MODE> __device__ void row_phase(const Args& a, int layer, int nrows, bool write_hx, LAS float* rl) {
    const int tid = otid(), lane = tid & 63, gw = blockIdx.x * 8 + (tid >> 6), nw = gridDim.x * 8;
    const float* MOD = (const float*)(a.ws + WS_MOD); const bf16_t* Yb = (const bf16_t*)(a.ws + WS_Y); const float* YP = (const float*)(a.ws + WS_YP);
    bf16_t* XB = (bf16_t*)(a.ws + WS_XB); bf16_t* HX = (bf16_t*)(a.ws + WS_HX);
    const int nl = (MODE == 2) ? layer + 1 : layer;
    const float* gpost = (MODE == 1 ? a.in[I_GPOSTMIX] : a.in[I_GPOSTFFN]) + layer * D;
    const float* gpre = (MODE == 1 ? a.in[I_GPREFFN] + layer * D : a.in[I_GPREMIX] + nl * D);
    for (int r = gw; r < nrows; r += nw) {
        const int mr = r < MX ? (r >> 11) : 8;
        bf16_t* xb = XB + (size_t)r * D;
        f32x4 v[8];
        if (MODE == 0) { const float* src = r < MX ? a.in[I_X] + (size_t)r * D : a.in[I_CTX] + (size_t)(r - MX) * D;
#pragma unroll
            for (int i = 0; i < 8; ++i) v[i] = *(const f32x4*)(src + lane * 4 + 256 * i);
        } else {
            const float* gate = MOD + ((size_t)layer * 9 + mr) * 6 * D + (MODE == 1 ? 2 : 5) * D;
            const float* xs = r < MX ? a.in[I_X] + (size_t)r * D : a.in[I_CTX] + (size_t)(r - MX) * D;
            f32x4 y[8]; float ss = 0.f;
#pragma unroll
            for (int i = 0; i < 8; ++i) {
                if (r < MX) { const u32x2 t = *(const u32x2*)(Yb + (size_t)r * D + lane * 4 + 256 * i); y[i] = (f32x4){bflo(t.x), bfhi(t.x), bflo(t.y), bfhi(t.y)}; }
                else { const float* p = YP + (size_t)(r - MX) * D + lane * 4 + 256 * i; y[i] = *(const f32x4*)p + *(const f32x4*)(p + (size_t)MC * D) + *(const f32x4*)(p + (size_t)2 * MC * D) + *(const f32x4*)(p + (size_t)3 * MC * D); }
                ss += y[i][0] * y[i][0] + y[i][1] * y[i][1] + y[i][2] * y[i][2] + y[i][3] * y[i][3]; }
            ss = wave_sum(ss); const float rn = rsqrtf(ss * (1.f / D) + EPS);
#pragma unroll
            for (int i = 0; i < 8; ++i) { const int c = lane * 4 + 256 * i; f32x4 xv;
                if (MODE == 1 && layer == 0) xv = *(const f32x4*)(xs + c); else { const u32x2 t = *(const u32x2*)(xb + c); xv = (f32x4){bflo(t.x), bfhi(t.x), bflo(t.y), bfhi(t.y)}; }
                const f32x4 gp = *(const f32x4*)(gpost + c), gt = *(const f32x4*)(gate + c);
                v[i] = xv + gt * (y[i] * rn * gp); }
        }
        if (MODE == 2 && !write_hx) {
#pragma unroll
            for (int i = 0; i < 8; ++i) *(f32x4*)(a.out + (size_t)r * D + lane * 4 + 256 * i) = v[i];
        } else if (MODE != 0) {
#pragma unroll
            for (int i = 0; i < 8; ++i) { u32x2 w; w.x = pg8::cvt_pk_bf16(v[i][0], v[i][1]); w.y = pg8::cvt_pk_bf16(v[i][2], v[i][3]); *(u32x2*)(xb + lane * 4 + 256 * i) = w; } }
        if (write_hx) {
            const float* mn = MOD + ((size_t)nl * 9 + mr) * 6 * D; const float* sh = mn + (MODE == 1 ? 3 : 0) * D; const float* sc = mn + (MODE == 1 ? 4 : 1) * D;
            float ss = 0.f;
#pragma unroll
            for (int i = 0; i < 8; ++i) ss += v[i][0] * v[i][0] + v[i][1] * v[i][1] + v[i][2] * v[i][2] + v[i][3] * v[i][3];
            ss = wave_sum(ss); const float rn = rsqrtf(ss * (1.f / D) + EPS);
            f32x4 hq[8];
#pragma unroll
            for (int i = 0; i < 8; ++i) { const int c = lane * 4 + 256 * i; const f32x4 g = *(const f32x4*)(gpre + c), s1 = *(const f32x4*)(sc + c), s0 = *(const f32x4*)(sh + c);
                hq[i] = v[i] * rn * g * (s1 + 1.f) + s0; }
            if (MODE != 1) {
#pragma unroll
                for (int i = 0; i < 8; ++i) { u32x2 w; w.x = pg8::cvt_pk_bf16(hq[i][0], hq[i][1]); w.y = pg8::cvt_pk_bf16(hq[i][2], hq[i][3]); *(u32x2*)(HX + (size_t)r * D + lane * 4 + 256 * i) = w; }
            } else {
                float am = 0.f;
#pragma unroll
                for (int i = 0; i < 8; ++i) am = fmaxf(am, fmaxf(fmaxf(fabsf(hq[i][0]), fabsf(hq[i][1])), fmaxf(fabsf(hq[i][2]), fabsf(hq[i][3]))));
#pragma unroll
                for (int o = 32; o; o >>= 1) am = fmaxf(am, __shfl_xor(am, o));
                const float inv = am > 0.f ? 127.f / am : 0.f;
                unsigned char* hxq = (unsigned char*)HX + (size_t)r * D;
#pragma unroll
                for (int i = 0; i < 8; ++i) { const unsigned q0 = (unsigned)(int)__builtin_rintf(hq[i][0] * inv) & 0xffu, q1 = (unsigned)(int)__builtin_rintf(hq[i][1] * inv) & 0xffu, q2 = (unsigned)(int)__builtin_rintf(hq[i][2] * inv) & 0xffu, q3 = (unsigned)(int)__builtin_rintf(hq[i][3] * inv) & 0xffu;
                    *(unsigned*)(hxq + lane * 4 + 256 * i) = q0 | (q1 << 8) | (q2 << 16) | (q3 << 24); }
                if (lane == 0) ((float*)(a.ws + WS_RSC))[r] = am * (1.f / 127.f);
            }
            if (MODE == 2 && r >= MX && nl == DEPTH - 1) {
                const float* wg = a.in[I_WIN] + (size_t)nl * D * DIN + C_G; float* gout = (float*)(a.ws + WS_GATES) + (size_t)r * 32;
                LAS float* hl = rl + (tid >> 6) * D;
#pragma unroll
                for (int i = 0; i < 8; ++i) *(LAS f32x4*)(hl + lane * 4 + 256 * i) = hq[i];
                f32x4 ga[8];
#pragma unroll
                for (int q = 0; q < 8; ++q) ga[q] = (f32x4){0.f, 0.f, 0.f, 0.f};
                for (int k = lane; k < D; k += 64) { const float hj = hl[k]; const float* wr = wg + (size_t)k * DIN;
#pragma unroll
                    for (int q = 0; q < 8; ++q) ga[q] += *(const f32x4*)(wr + 4 * q) * hj; }
#pragma unroll
                for (int q = 0; q < 8; ++q)
#pragma unroll
                    for (int j = 0; j < 4; ++j) { const float s = wave_sum(ga[q][j]); if (lane == 0) gout[q * 4 + j] = s; }
                }

        }
    }
}

__device__ void conva_phase(const Args& a, int layer, int nitems, LAS float* yl  ) {
#ifdef CA_STUB
    return;
#endif
    const int tid = otid(), lane = tid & 63, wv = tid >> 6;
    const bf16_t* PROJ = (const bf16_t*)(a.ws + WS_PROJ); bf16_t* MIX = (bf16_t*)(a.ws + WS_MIX);
    const float* cw = a.in[I_CAW] + (size_t)layer * KA * DCONV;
    LAS unsigned short* ul = (LAS unsigned short*)yl; LAS float* yt = yl + 94 * 512 / 2;
    for (int item = blockIdx.x; item < nitems; item += gridDim.x) {
        int rowbase, t0, lo, hi;
        if (item < 256) { rowbase = (item >> 5) * SEQ; t0 = (item & 31) * 64; lo = t0; hi = t0 + 64; }
        else { const int ci = item - 256; rowbase = MX + (ci >> 2) * CTXL; t0 = (ci & 3) * 64; lo = 0; hi = CTXL; }
#pragma unroll
        for (int kb = 0; kb < 2; ++kb) { u32x4 av[6], gv[6];
#pragma unroll
          for (int k = 0; k < 6; ++k) { const int i = wv + 8 * (kb * 6 + k), t = t0 - 15 + i; av[k] = (u32x4){0u, 0u, 0u, 0u}; gv[k] = av[k];
              if (i < 94 && t >= lo && t < hi) { const bf16_t* p = PROJ + (size_t)(rowbase + t) * DP + lane * 8; av[k] = *(const u32x4*)(p + P_AVAL); gv[k] = *(const u32x4*)(p + P_AGATE); } }
#pragma unroll
          for (int k = 0; k < 6; ++k) { const int i = wv + 8 * (kb * 6 + k);
              if (i < 94) { u32x4 o;
                  o.x = pg8::cvt_pk_bf16(bflo(av[k].x) * sigmoidf_(bflo(gv[k].x)), bfhi(av[k].x) * sigmoidf_(bfhi(gv[k].x)));
                  o.y = pg8::cvt_pk_bf16(bflo(av[k].y) * sigmoidf_(bflo(gv[k].y)), bfhi(av[k].y) * sigmoidf_(bfhi(gv[k].y)));
                  o.z = pg8::cvt_pk_bf16(bflo(av[k].z) * sigmoidf_(bflo(gv[k].z)), bfhi(av[k].z) * sigmoidf_(bfhi(gv[k].z)));
                  o.w = pg8::cvt_pk_bf16(bflo(av[k].w) * sigmoidf_(bflo(gv[k].w)), bfhi(av[k].w) * sigmoidf_(bfhi(gv[k].w)));
                  *(LAS u32x4*)(ul + i * 512 + lane * 8) = o; } } }
        float w[KA];
#pragma unroll
        for (int k = 0; k < KA; ++k) w[k] = cw[k * DCONV + tid];
        const float bias = a.in[I_CAB][layer * DCONV + tid];
        LDS_BARRIER();
        for (int qq = 0; qq < 4; ++qq) {
            float u[46];
#pragma unroll
            for (int i = 0; i < 46; ++i) u[i] = bf2f(ul[(qq * 16 + i) * 512 + tid]);
#pragma unroll
            for (int tt = 0; tt < 16; ++tt) { float y = bias;
#pragma unroll
                for (int k = 0; k < KA; ++k) y += w[k] * u[tt + k];
                yt[tt * 512 + tid] = y; }
            LDS_BARRIER();
#pragma unroll
            for (int q = 0; q < 2; ++q) { const int tt = wv * 2 + q; const LAS float* yr = yt + tt * 512 + lane * 8;
                const f32x4 y0 = *(const LAS f32x4*)yr, y1 = *(const LAS f32x4*)(yr + 4);
                float s = y0[0] + y0[1] + y0[2] + y0[3] + y1[0] + y1[1] + y1[2] + y1[3]; s = wave_sum(s); const float mu = s * (1.f / DCONV);
                const f32x4 d0 = y0 - mu, d1 = y1 - mu;
                float vs = d0[0] * d0[0] + d0[1] * d0[1] + d0[2] * d0[2] + d0[3] * d0[3] + d1[0] * d1[0] + d1[1] * d1[1] + d1[2] * d1[2] + d1[3] * d1[3]; vs = wave_sum(vs);
                const float rs = rsqrtf(vs * (1.f / DCONV) + EPS);
                const float* lw = a.in[I_LNAW] + layer * DCONV + lane * 8; const float* lb = a.in[I_LNAB] + layer * DCONV + lane * 8;
                float o[8];
#pragma unroll
                for (int j = 0; j < 4; ++j) { float z0 = d0[j] * rs * lw[j] + lb[j], z1 = d1[j] * rs * lw[4 + j] + lb[4 + j]; o[j] = z0 * sigmoidf_(z0); o[4 + j] = z1 * sigmoidf_(z1); }
                u32x4 pk; pk.x = pg8::cvt_pk_bf16(o[0], o[1]); pk.y = pg8::cvt_pk_bf16(o[2], o[3]); pk.z = pg8::cvt_pk_bf16(o[4], o[5]); pk.w = pg8::cvt_pk_bf16(o[6], o[7]);
                *(u32x4*)(MIX + (size_t)(rowbase + t0 + qq * 16 + tt) * D + lane * 8) = pk; }
            LDS_BARRIER();
        }
    }
}

__device__ __forceinline__ void sc_u(const bf16_t* p, float (&u)[8]) {
    const u32x4 x = *(const u32x4*)(p + P_SIN), c = *(const u32x4*)(p + P_SC);
    u[0] = bflo(x.x) * bflo(c.x); u[1] = bfhi(x.x) * bfhi(c.x); u[2] = bflo(x.y) * bflo(c.y); u[3] = bfhi(x.y) * bfhi(c.y);
    u[4] = bflo(x.z) * bflo(c.z); u[5] = bfhi(x.z) * bfhi(c.z); u[6] = bflo(x.w) * bflo(c.w); u[7] = bfhi(x.w) * bfhi(c.w); }
__device__ void shortconv_phase(const Args& a, int layer, int nrows) {
    const int tid = otid(), lane = tid & 63, gw = blockIdx.x * 8 + (tid >> 6), nw = gridDim.x * 8;
    const bf16_t* PROJ = (const bf16_t*)(a.ws + WS_PROJ); bf16_t* MIX = (bf16_t*)(a.ws + WS_MIX);
    const float* cw = a.in[I_CCW] + (size_t)layer * 3 * 512 + lane * 8;
    float w0[8], w1[8], w2[8];
#pragma unroll
    for (int j = 0; j < 8; ++j) { w0[j] = cw[j]; w1[j] = cw[512 + j]; w2[j] = cw[1024 + j]; }
    for (int r = gw; r < nrows; r += nw) {
        int dlt; bool hp, hn;
        if (r < MX) { const int g = (r & (SEQ - 1)) >> 6; dlt = 64; hp = g > 0; hn = g < 31; } else { const int t = (r - MX) & (CTXL - 1); dlt = 1; hp = t > 0; hn = t < CTXL - 1; }
        const bf16_t* p = PROJ + (size_t)r * DP + lane * 8;
        float uc[8], up[8], un[8];
        sc_u(p, uc);
        if (hp) sc_u(p - (size_t)dlt * DP, up); else {
#pragma unroll
            for (int j = 0; j < 8; ++j) up[j] = 0.f; }
        if (hn) sc_u(p + (size_t)dlt * DP, un); else {
#pragma unroll
            for (int j = 0; j < 8; ++j) un[j] = 0.f; }
        const u32x4 sb = *(const u32x4*)(p + P_SB);
        const float b[8] = {bflo(sb.x), bfhi(sb.x), bflo(sb.y), bfhi(sb.y), bflo(sb.z), bfhi(sb.z), bflo(sb.w), bfhi(sb.w)};
        float o[8];
#pragma unroll
        for (int j = 0; j < 8; ++j) o[j] = b[j] * (w0[j] * up[j] + w1[j] * uc[j] + w2[j] * un[j]);
        u32x4 pk; pk.x = pg8::cvt_pk_bf16(o[0], o[1]); pk.y = pg8::cvt_pk_bf16(o[2], o[3]); pk.z = pg8::cvt_pk_bf16(o[4], o[5]); pk.w = pg8::cvt_pk_bf16(o[6], o[7]);
        *(u32x4*)(MIX + (size_t)r * D + 1536 + lane * 8) = pk;
    }
}

__device__ void mlstm_out_phase(const Args& a, int layer, int nrows) {
    const int tid = otid(), lane = tid & 63, gw = blockIdx.x * 8 + (tid >> 6), nw = gridDim.x * 8;
    const bf16_t* PROJ = (const bf16_t*)(a.ws + WS_PROJ); bf16_t* MIX = (bf16_t*)(a.ws + WS_MIX);
    const bf16_t* HF = (const bf16_t*)(a.ws + WS_Y); const bf16_t* HB = HF + (size_t)MT * DML;
    const float* nwp = a.in[I_MNW] + layer * DML + lane * 16;
    float nwv[16];
#pragma unroll
    for (int j = 0; j < 16; ++j) nwv[j] = nwp[j];
    for (int r = gw; r < nrows; r += nw) {
        float hv[16], ov[16];
#pragma unroll
        for (int q = 0; q < 2; ++q) {
            const u32x4 f = *(const u32x4*)(HF + (size_t)r * DML + lane * 16 + q * 8), g = *(const u32x4*)(HB + (size_t)r * DML + lane * 16 + q * 8);
            const u32x4 o = *(const u32x4*)(PROJ + (size_t)r * DP + P_O + lane * 16 + q * 8);
            hv[q * 8 + 0] = bflo(f.x) + bflo(g.x); hv[q * 8 + 1] = bfhi(f.x) + bfhi(g.x); hv[q * 8 + 2] = bflo(f.y) + bflo(g.y); hv[q * 8 + 3] = bfhi(f.y) + bfhi(g.y);
            hv[q * 8 + 4] = bflo(f.z) + bflo(g.z); hv[q * 8 + 5] = bfhi(f.z) + bfhi(g.z); hv[q * 8 + 6] = bflo(f.w) + bflo(g.w); hv[q * 8 + 7] = bfhi(f.w) + bfhi(g.w);
            ov[q * 8 + 0] = bflo(o.x); ov[q * 8 + 1] = bfhi(o.x); ov[q * 8 + 2] = bflo(o.y); ov[q * 8 + 3] = bfhi(o.y); ov[q * 8 + 4] = bflo(o.z); ov[q * 8 + 5] = bfhi(o.z); ov[q * 8 + 6] = bflo(o.w); ov[q * 8 + 7] = bfhi(o.w); }
        float s = 0.f;
#pragma unroll
        for (int j = 0; j < 16; ++j) s += hv[j];
        s += __shfl_xor(s, 1); s += __shfl_xor(s, 2); s += __shfl_xor(s, 4); const float mu = s * (1.f / DH);
        float vs = 0.f;
#pragma unroll
        for (int j = 0; j < 16; ++j) { hv[j] -= mu; vs += hv[j] * hv[j]; }
        vs += __shfl_xor(vs, 1); vs += __shfl_xor(vs, 2); vs += __shfl_xor(vs, 4); const float rs = rsqrtf(vs * (1.f / DH) + EPS);
        float o[16];
#pragma unroll
        for (int j = 0; j < 16; ++j) o[j] = hv[j] * rs * nwv[j] * sigmoidf_(ov[j]);
#pragma unroll
        for (int q = 0; q < 2; ++q) { u32x4 pk; pk.x = pg8::cvt_pk_bf16(o[q * 8 + 0], o[q * 8 + 1]); pk.y = pg8::cvt_pk_bf16(o[q * 8 + 2], o[q * 8 + 3]); pk.z = pg8::cvt_pk_bf16(o[q * 8 + 4], o[q * 8 + 5]); pk.w = pg8::cvt_pk_bf16(o[q * 8 + 6], o[q * 8 + 7]);
            *(u32x4*)(MIX + (size_t)r * D + 512 + lane * 16 + q * 8) = pk; }
    }
}

constexpr int L_Q = 0, L_K = 17408, L_V = 34816, L_P = 46080, L_CT = 55296, L_S = 77056, L_H = 104704, L_W = 113920;
__device__ __forceinline__ int ml_row(int c, int j, int dir, int b) {
    int T, base, cl; if (c < 4) { T = CTXL; base = MX + b * CTXL; cl = c; } else { T = SEQ; base = b * SEQ; cl = c - 4; }
    int t = cl * 64 + j; if (dir) t = T - 1 - t; return base + t; }
__device__ __forceinline__ bf16x8 tr_frag(const LAS unsigned char* p, int rowpitch4) {
    const s16x4 lo = __builtin_amdgcn_ds_read_tr16_b64_v4i16((LAS s16x4*)p), hi = __builtin_amdgcn_ds_read_tr16_b64_v4i16((LAS s16x4*)(p + rowpitch4));
    return __builtin_shufflevector(lo, hi, 0, 1, 2, 3, 4, 5, 6, 7); }
#define MFMA16(a_, b_, c_) __builtin_amdgcn_mfma_f32_16x16x32_bf16(a_, b_, c_, 0, 0, 0)
__device__ void mlstm_phase(const Args& a, int layer, bool last, LAS unsigned char* lds) {
    const int tid = otid(), lane = tid & 63, w = __builtin_amdgcn_readfirstlane(tid >> 6), fr = lane & 15, fq = lane >> 4, q4 = fr >> 2, p4 = fr & 3;
    const float* GATES = (const float*)(a.ws + WS_GATES);
    LAS float* gA = (LAS float*)(lds + L_S); LAS float* gPM = gA + 36 * 64; LAS float* gB = gPM + 36 * 64;
    const int mj = w & 3, hf = w >> 2;
    for (int item = blockIdx.x; item < 256; item += gridDim.x) {
        const int eh = (item >> 3) & 1, chain = (item & 7) | ((item >> 4) << 3), dir = chain & 1, hd = (chain >> 1) & 7, b = chain >> 4;
        bf16_t* Hout = (bf16_t*)(a.ws + WS_Y) + (size_t)dir * MT * DML + hd * DH + eh * 64;
        const float bi = a.in[I_BGATES][layer * 32 + dir * 16 + hd], bfg = a.in[I_BGATES][layer * 32 + dir * 16 + 8 + hd];
        const bf16_t* QKVH = (const bf16_t*)(a.ws + WS_QKVH);
        const bf16_t* pq = QKVH + (size_t)(0 * NH + hd) * MT * DH; const bf16_t* pk = QKVH + (size_t)(1 * NH + hd) * MT * DH; const bf16_t* pv = QKVH + (size_t)(2 * NH + hd) * MT * DH + eh * 64;
        const float* pgi = GATES + dir * 16 + hd; const float* pgf = pgi + 8;
        for (int i = tid; i < 80 * 136 / 2; i += 512) ((LAS unsigned*)(lds + L_CT))[i] = 0u;
        { const int s = tid >> 3, c = tid & 7; ((LAS unsigned*)(lds + L_V + s * 176 + 128))[c] = 0x3F803F80u; }
        float gi5[5], gf5[5];
#pragma unroll
        for (int q = 0; q < 5; ++q) { const int c = w + 8 * q; gi5[q] = 0.f; gf5[q] = 0.f;
            if (c < 36) { const size_t Rg = (size_t)ml_row(c, lane, dir, b) * 32; gi5[q] = pgi[Rg] + bi; gf5[q] = pgf[Rg] + bfg; } }
#pragma unroll
        for (int q = 0; q < 5; ++q) { const int c = w + 8 * q;
            if (c < 36) { const float gi = gi5[q], gf = gf5[q];
            const float lf = fminf(gf, 0.f) - log1pf(expf(-fabsf(gf)));
            float bc = lf;
#pragma unroll
            for (int o = 1; o < 64; o <<= 1) { const float t = __shfl_up(bc, o); if (lane >= o) bc += t; }
            const float aa = gi - bc; float pm = aa;
#pragma unroll
            for (int o = 1; o < 64; o <<= 1) { const float t = __shfl_up(pm, o); if (lane >= o) pm = fmaxf(pm, t); }
            gA[c * 64 + lane] = aa; gPM[c * 64 + lane] = pm; gB[c * 64 + lane] = bc; } }
        f32x4 Cacc[5];
#pragma unroll
        for (int e = 0; e < 5; ++e) Cacc[e] = (f32x4){0.f, 0.f, 0.f, 0.f};
        float m_prev = 0.f;
        u32x4 qv[2], kv[2], vv;
        const int srow0 = tid >> 4, scv = tid & 15, vrow = tid >> 3, vcv = tid & 7;
#define ML_LOAD(Q_, K_, V_, cc) do { \
        _Pragma("unroll") for (int i_ = 0; i_ < 2; ++i_) { const size_t R_ = (size_t)ml_row(cc, srow0 + 32 * i_, dir, b) * DH + scv * 8; Q_[i_] = *(const u32x4*)(pq + R_); K_[i_] = *(const u32x4*)(pk + R_); } \
        V_ = *(const u32x4*)(pv + (size_t)ml_row(cc, vrow, dir, b) * DH + vcv * 8); } while (0)
        ML_LOAD(qv, kv, vv, 0);
        __syncthreads();
        for (int c = 0; c < 36; ++c) {
            const LAS float* cA = gA + c * 64; const LAS float* cPM = gPM + c * 64; const LAS float* cB = gB + c * 64;
            const float M63 = fmaxf(m_prev, cPM[63]), decay = __expf(m_prev - M63), m_next = cB[63] + M63;
            if (w == 0) { const float Ml = fmaxf(m_prev, cPM[lane]); LAS float* sw = (LAS float*)(lds + L_W);
                sw[lane] = __expf(cA[lane] - M63); sw[64 + lane] = __expf(m_prev - Ml); sw[128 + lane] = __expf(-(cB[lane] + Ml)); }
#pragma unroll
            for (int i = 0; i < 2; ++i) { *(LAS u32x4*)(lds + L_Q + (srow0 + 32 * i) * 272 + scv * 16) = qv[i]; *(LAS u32x4*)(lds + L_K + (srow0 + 32 * i) * 272 + scv * 16) = kv[i]; }
            *(LAS u32x4*)(lds + L_V + vrow * 176 + vcv * 16) = vv;
            if (c > 0 && !(last && c - 1 < 4)) { const u32x4 hv = *(const LAS u32x4*)(lds + L_H + vrow * 144 + vcv * 16); *(u32x4*)(Hout + (size_t)ml_row(c - 1, vrow, dir, b) * DML + vcv * 8) = hv; }
            if (c + 1 < 36) ML_LOAD(qv, kv, vv, c + 1);
            LDS_BARRIER();
            f32x4 nacc[3]; float Mr[4]; const int jr = mj * 16 + fr;
#ifndef REP_SEG2
#define REP_SEG2 0
#endif
            for (int r2_ = 0; r2_ <= REP_SEG2; ++r2_) {
            bf16x8 aq[4], bk[2][4], bcf[3][4];
#pragma unroll
            for (int ks = 0; ks < 4; ++ks) aq[ks] = *(const LAS bf16x8*)(lds + L_Q + (mj * 16 + fr) * 272 + ks * 64 + fq * 16);
#pragma unroll
            for (int t2 = 0; t2 < 2; ++t2)
#pragma unroll
                for (int ks = 0; ks < 4; ++ks) bk[t2][ks] = *(const LAS bf16x8*)(lds + L_K + ((2 * hf + t2) * 16 + fr) * 272 + ks * 64 + fq * 16);
#pragma unroll
            for (int i = 0; i < 3; ++i) { const int et = (i < 2) ? 2 * hf + i : 4;
#pragma unroll
                for (int ks = 0; ks < 4; ++ks) bcf[i][ks] = *(const LAS bf16x8*)(lds + L_CT + (et * 16 + fr) * 272 + ks * 64 + fq * 16); }
            Mr[0] = fmaxf(m_prev, cPM[jr]);
            const float wi = ((const LAS float*)(lds + L_W))[64 + jr];
#pragma unroll
            for (int t2 = 0; t2 < 2; ++t2) { const int ns = 2 * hf + t2; f32x4 s = (f32x4){0.f, 0.f, 0.f, 0.f};
                if (ns <= mj) {
#pragma unroll
                    for (int ks = 0; ks < 4; ++ks) s = MFMA16(bk[t2][ks], aq[ks], s); }
                const int s0 = ns * 16 + fq * 4; const f32x4 as4 = *(const LAS f32x4*)(cA + s0);
                float p[4];
#pragma unroll
                for (int jj = 0; jj < 4; ++jj) p[jj] = (s0 + jj <= jr) ? s[jj] * __expf(as4[jj] - Mr[0]) : 0.f;
                u32x2 pk; pk.x = pg8::cvt_pk_bf16(p[0], p[1]); pk.y = pg8::cvt_pk_bf16(p[2], p[3]);
                *(LAS u32x2*)(lds + L_P + jr * 144 + s0 * 2) = pk; }
#pragma unroll
            for (int i = 0; i < 3; ++i) { f32x4 n = (f32x4){0.f, 0.f, 0.f, 0.f};
#pragma unroll
                for (int ks = 0; ks < 4; ++ks) n = MFMA16(bcf[i][ks], aq[ks], n);
                nacc[i] = n * wi; }
            }
            LDS_BARRIER();
            bf16x8 ap[2], bv[5][2], akr[2];
            const float fl = ((const LAS float*)(lds + L_W))[128 + jr];
#pragma unroll
            for (int k2 = 0; k2 < 2; ++k2) ap[k2] = *(const LAS bf16x8*)(lds + L_P + (mj * 16 + fr) * 144 + k2 * 64 + fq * 16);
#pragma unroll
            for (int et = 0; et < 5; ++et)
#pragma unroll
                for (int k2 = 0; k2 < 2; ++k2) bv[et][k2] = tr_frag(lds + L_V + (k2 * 32 + fq * 8 + q4) * 176 + (et * 16 + 4 * p4) * 2, 4 * 176);
#pragma unroll
            for (int k2 = 0; k2 < 2; ++k2) akr[k2] = tr_frag(lds + L_K + (k2 * 32 + fq * 8 + q4) * 272 + (w * 16 + 4 * p4) * 2, 4 * 272);
#pragma unroll
            for (int i = 0; i < 3; ++i)
#pragma unroll
                for (int k2 = 0; k2 < 2; ++k2) { if (hf == 0) nacc[i] = MFMA16(bv[i < 2 ? i : 4][k2], ap[k2], nacc[i]); else nacc[i] = MFMA16(bv[i < 2 ? 2 + i : 4][k2], ap[k2], nacc[i]); }
            { const float dn = __builtin_amdgcn_rcpf(fmaxf(fabsf(nacc[2][0]), fl));
#pragma unroll
              for (int i = 0; i < 2; ++i) { const f32x4 hv4 = nacc[i] * dn; u32x2 pk; pk.x = pg8::cvt_pk_bf16(hv4[0], hv4[1]); pk.y = pg8::cvt_pk_bf16(hv4[2], hv4[3]);
                  *(LAS u32x2*)(lds + L_H + jr * 144 + ((2 * hf + i) * 16 + fq * 4) * 2) = pk; } }
            bf16x8 ak[2];
#pragma unroll
            for (int k2 = 0; k2 < 2; ++k2) { const bf16x8 raw = akr[k2];
                const f32x4 a0 = *(const LAS f32x4*)(lds + L_W + (k2 * 32 + fq * 8) * 4), a1 = *(const LAS f32x4*)(lds + L_W + (k2 * 32 + fq * 8 + 4) * 4);
                const float wt[8] = {a0[0], a0[1], a0[2], a0[3], a1[0], a1[1], a1[2], a1[3]};
                u32x4 pk4; pk4.x = pg8::cvt_pk_bf16(bf2f((unsigned short)raw[0]) * wt[0], bf2f((unsigned short)raw[1]) * wt[1]); pk4.y = pg8::cvt_pk_bf16(bf2f((unsigned short)raw[2]) * wt[2], bf2f((unsigned short)raw[3]) * wt[3]);
                pk4.z = pg8::cvt_pk_bf16(bf2f((unsigned short)raw[4]) * wt[4], bf2f((unsigned short)raw[5]) * wt[5]); pk4.w = pg8::cvt_pk_bf16(bf2f((unsigned short)raw[6]) * wt[6], bf2f((unsigned short)raw[7]) * wt[7]);
                ak[k2] = __builtin_bit_cast(bf16x8, pk4); }
#pragma unroll
            for (int et = 0; et < 5; ++et) { f32x4 cc = Cacc[et] * decay;
#pragma unroll
                for (int k2 = 0; k2 < 2; ++k2) cc = MFMA16(ak[k2], bv[et][k2], cc);
                Cacc[et] = cc;
                u32x2 pk2; pk2.x = pg8::cvt_pk_bf16(cc[0], cc[1]); pk2.y = pg8::cvt_pk_bf16(cc[2], cc[3]);
                *(LAS u32x2*)(lds + L_CT + (et * 16 + fr) * 272 + (w * 16 + fq * 4) * 2) = pk2; }
            m_prev = m_next;
            LDS_BARRIER();
        }
        { const u32x4 hv = *(const LAS u32x4*)(lds + L_H + vrow * 144 + vcv * 16); *(u32x4*)(Hout + (size_t)ml_row(35, vrow, dir, b) * DML + vcv * 8) = hv; }
        __syncthreads();
#undef ML_LOAD
    }
}

constexpr int NPH = 2 + 8 * DEPTH;
#ifndef REP_P0
#define REP_P0 0
#endif
#ifndef REP_ML
#define REP_ML 0
#endif
#ifndef REP_GEMM
#define REP_GEMM 0
#endif
#ifndef REP_G0
#define REP_G0 0
#endif
#ifndef REP_G1
#define REP_G1 0
#endif
#ifndef REP_G2
#define REP_G2 0
#endif
#ifndef REP_G3
#define REP_G3 0
#endif
#ifndef HOT_G0
#define HOT_G0 0
#endif
#ifndef REP_ROW0
#define REP_ROW0 0
#endif
#ifndef REP_CA
#define REP_CA 0
#endif
#ifndef REP_SC
#define REP_SC 0
#endif
#ifndef REP_MO
#define REP_MO 0
#endif
#ifndef REP_CV
#define REP_CV 0
#endif
#ifndef REP_MODS
#define REP_MODS 0
#endif
#ifndef REP_MIX
#define REP_MIX 0
#endif
__device__ void convert_layer(const Args& a, int l, LAS unsigned char* lds) {
    unsigned char* wl = a.ws + WS_W;
    for (int m = 0; m < 4; ++m) {
        const float* W; int K, N, Npad, klo = -1, khi = -1; size_t off;
        if (m == 0) { W = a.in[I_WIN] + (size_t)l * D * DIN; K = D; N = DIN; Npad = DINP; off = 0; klo = C_K; khi = C_V; }
        else if (m == 1) { W = a.in[I_WOUT] + (size_t)l * D * D; K = D; N = D; Npad = D; off = SZ_WIN; }
        else if (m == 2) { W = a.in[I_WFF1] + (size_t)l * D * DFF; K = D; N = DFF; Npad = DFF; off = SZ_WIN + SZ_WOUT; }
        else { W = a.in[I_WFF2] + (size_t)l * DFF * D; K = DFF; N = D; Npad = D; off = SZ_WIN + SZ_WOUT + SZ_WFF; }
        convert_matrix(W, K, N, Npad, (bf16_t*)(wl + off), klo, khi, (LAS float*)lds, m == 2 ? (const float*)(a.ws + WS_CMAX) + (size_t)l * DFF : nullptr, (float*)(a.ws + WS_CSC) + (size_t)l * DFF);
    }
}
__global__ void __launch_bounds__(512, 2) mega(Args a) {
    extern __shared__ __attribute__((aligned(16))) unsigned char shm[];
    LAS unsigned char* lds = (LAS unsigned char*)shm;
#ifdef ONLY_CA
    conva_phase(a, a.ph_lo, 288, (LAS float*)lds); return;
#endif
    const int lo = a.ph_lo, hi = a.ph_hi;
    if (threadIdx.x < 4) ((LAS unsigned*)(lds + LDS_BARST))[threadIdx.x] = 0u;
    __syncthreads();
    XcdBarrier xbar; xbar.bar = (unsigned*)(a.ws + WS_BAR); xbar.x = 0; xbar.st = nullptr;
    if (hi - lo > 1) xbar = xcd_barrier_post((unsigned*)(a.ws + WS_BAR), (volatile LAS unsigned*)(lds + LDS_BARST));
#define IN(k) (lo <= (k) && (k) < hi)
#ifndef REP_SYNC
#define REP_SYNC 0
#endif
#define SYNC(k) do { if (IN(k) && IN((k) + 1)) for (int rs_ = 0; rs_ <= REP_SYNC; ++rs_) { if ((k) == 0) cg::this_grid().sync(); else xcd_barrier(xbar); } } while (0)
    bf16_t* HX = (bf16_t*)(a.ws + WS_HX); bf16_t* PROJ = (bf16_t*)(a.ws + WS_PROJ); bf16_t* MIX = (bf16_t*)(a.ws + WS_MIX); bf16_t* H1 = PROJ;
    bf16_t* Yb = (bf16_t*)(a.ws + WS_Y); float* YP = (float*)(a.ws + WS_YP); float* GATES = (float*)(a.ws + WS_GATES);
    if (IN(0)) for (int rep = 0; rep <= REP_P0; ++rep) {
        colmax_phase(a, (LAS float*)lds);
        for (int r_ = 0; r_ <= REP_MODS; ++r_) mods_phase(a, (LAS float*)lds);
    }
    SYNC(0);
    if (IN(1)) { for (int rep = 0; rep <= REP_ROW0; ++rep) row_phase<0>(a, 0, MT, true, (LAS float*)lds); __syncthreads(); for (int r_ = 0; r_ <= REP_CV; ++r_) convert_layer(a, 0, lds); }
    SYNC(1);
    for (int l = 0; l < DEPTH; ++l) {
        const bool last = (l == DEPTH - 1); const int M2 = last ? MX : MT, pb = 2 + 8 * l;
        const bf16_t* wl = (const bf16_t*)(a.ws + WS_W);
        const bf16_t* WIN = wl; const bf16_t* WOUT = (const bf16_t*)((const unsigned char*)wl + SZ_WIN);
        const bf16_t* WF1 = (const bf16_t*)((const unsigned char*)wl + SZ_WIN + SZ_WOUT); const bf16_t* WF2 = (const bf16_t*)((const unsigned char*)wl + SZ_WIN + SZ_WOUT + SZ_WFF);
        if (IN(pb)) for (int rep = 0; rep <= REP_GEMM + REP_G0; ++rep) { pg8::Gemm g{HX, WIN, MT, DINP, D}; pg8::TailTilesOrder S; S.init(last ? MX : MT, DINP, D, last ? 64 : 0, 8, C_K / 256, (int)gridDim.x, (int)blockIdx.x);     pg8::EpiBf16<0> E{PROJ, DP, GATES, C_G / 256, (bf16_t*)(a.ws + WS_QKVH), MT}; pg8::gemm_phase(lds, g, S, E); }
        SYNC(pb);
        if (IN(pb + 1)) {
#ifndef SKIP_ML
 for (int rep = 0; rep <= REP_ML; ++rep) mlstm_phase(a, l, last, lds);
#endif
for (int rep = 0; rep <= REP_MIX + REP_CA; ++rep) conva_phase(a, l, last ? 256 : 288, (LAS float*)lds);
 for (int rep = 0; rep <= REP_MIX + REP_SC; ++rep) shortconv_phase(a, l, M2);
 }
        SYNC(pb + 1);
        if (IN(pb + 2)) for (int rep = 0; rep <= REP_MIX + REP_MO; ++rep) mlstm_out_phase(a, l, M2);
        SYNC(pb + 2);
        if (IN(pb + 3)) for (int rep = 0; rep <= REP_GEMM + REP_G1; ++rep) { pg8::Gemm g{MIX, WOUT, M2, D, D}; pg8::TailSplitOrder S; S.init(MX, D, D, last ? 0 : MC / 256, (int)gridDim.x, (int)blockIdx.x); pg8::EpiY E{Yb, D, YP, MX, (size_t)MC * D}; pg8::gemm_phase(lds, g, S, E); }
        SYNC(pb + 3);
        if (IN(pb + 4)) row_phase<1>(a, l, M2, true, (LAS float*)lds);
        SYNC(pb + 4);
        if (IN(pb + 5)) for (int rep = 0; rep <= REP_GEMM + REP_G2; ++rep) {
            pg8::Gemm g{HX, WF1, M2, DFF, D / 2}; pg8::StaticOrder S; S.init(M2, DFF, D / 2, (int)gridDim.x, (int)blockIdx.x);
            pg8::EpiSqReluI8 E{H1, DFF, (const float*)(a.ws + WS_RSC), (const float*)(a.ws + WS_CSC) + (size_t)l * DFF}; pg8::gemm_phase(lds, g, S, E); }
        SYNC(pb + 5);
        if (IN(pb + 6)) for (int rep = 0; rep <= REP_GEMM + REP_G3; ++rep) { pg8::Gemm g{H1, WF2, M2, D, DFF}; pg8::TailSplitOrder S; S.init(MX, D, DFF, last ? 0 : MC / 256, (int)gridDim.x, (int)blockIdx.x); pg8::EpiY E{Yb, D, YP, MX, (size_t)MC * D}; pg8::gemm_phase(lds, g, S, E); }
        SYNC(pb + 6);
        if (IN(pb + 7)) { row_phase<2>(a, l, M2, !last, (LAS float*)lds); __syncthreads(); if (!last) convert_layer(a, l + 1, lds); }
        SYNC(pb + 7);
    }
#undef IN
#undef SYNC
}

extern "C" void kernel_launch(void* const* d_in, const int* in_sizes, int n_in, void* d_out, int out_size, void* d_ws, size_t ws_size, hipStream_t stream) {
    static int grid = 0;
    if (grid == 0) {
        if (n_in != 21 || in_sizes[0] != MX * D || out_size != MX * D || ws_size < WS_END) { fprintf(stderr, "kernel_launch: unexpected shapes / workspace (n_in %d, ws %zu, need %zu)\n", n_in, ws_size, (size_t)WS_END); grid = -1; return; }
        int dev = 0, cus = 0, per_cu = 0;
        hipGetDevice(&dev); hipDeviceGetAttribute(&cus, hipDeviceAttributeMultiprocessorCount, dev);
        if (hipFuncSetAttribute((const void*)mega, hipFuncAttributeMaxDynamicSharedMemorySize, LDS_BYTES) != hipSuccess) { fprintf(stderr, "kernel_launch: hipFuncSetAttribute failed\n"); grid = -1; return; }
        if (hipOccupancyMaxActiveBlocksPerMultiprocessor(&per_cu, (const void*)mega, 512, LDS_BYTES) != hipSuccess || per_cu < 1) per_cu = 1;
        (void)hipGetLastError();
        grid = cus * 1;
    }
    if (grid < 0) return;
    Args a{};
    for (int i = 0; i < 21; ++i) a.in[i] = (const float*)d_in[i];
    a.out = (float*)d_out; a.ws = (unsigned char*)d_ws;
#if SINGLE_LAUNCH
    if (hipMemsetAsync((unsigned char*)d_ws + WS_BAR, 0, 16384, stream) != hipSuccess) { fprintf(stderr, "kernel_launch: memset failed\n"); return; }
    a.ph_lo = 0; a.ph_hi = NPH;
    void* args[] = {&a};
    hipError_t e = hipLaunchCooperativeKernel((const void*)mega, dim3(grid), dim3(512), args, LDS_BYTES, stream);
    if (e != hipSuccess) fprintf(stderr, "cooperative launch failed: %s (grid %d)\n", hipGetErrorString(e), grid);
#else
    for (int p = 0; p < NPH; ++p) { a.ph_lo = p; a.ph_hi = p + 1; hipLaunchKernelGGL(mega, dim3(grid), dim3(512), LDS_BYTES, stream, a); }
#endif
}
```

```cpp
#include <hip/hip_runtime.h>
#include <hip/hip_cooperative_groups.h>
#include <cstdio>
namespace cg = cooperative_groups;

#ifndef SINGLE_LAUNCH
#define SINGLE_LAUNCH 1
#endif
#ifndef REP_EPI
#define REP_EPI 0
#endif

namespace pg8 {
#define PG8_LAS __attribute__((address_space(3)))
typedef unsigned short bf16_t;
typedef short bf16x8 __attribute__((ext_vector_type(8)));
typedef float f32x4 __attribute__((ext_vector_type(4)));
typedef unsigned u32x4 __attribute__((ext_vector_type(4)));
constexpr int BM = 256, BK = 64, HALF = 128, HTB = HALF * BK * 2  , STAGE_BYTES = 8 * HTB, NXCD = 8, WGM = 8;

__host__ __device__ __forceinline__ int lds_byte(int r, int c) { const int st = (r >> 4) * 2 + (c >> 5), rr = r & 15, cc = c & 31, ob = rr * 64 + cc * 2; return st * 1024 + (ob ^ (((ob >> 9) & 1) << 5)); }
__host__ __device__ __forceinline__ void stage_rc(int b, int& R, int& C) { const int st = b / 1024, sb = b % 1024, swz = sb ^ (((sb >> 9) & 1) << 5); R = (st >> 1) * 16 + swz / 64; C = (st & 1) * 32 + (swz % 64) / 2; }
__host__ __device__ __forceinline__ int perm32(int rho) { const int n = rho >> 4, i = rho & 15; return 8 * (i >> 2) + 4 * n + (i & 3); }

typedef int i32x4 __attribute__((ext_vector_type(4)));
template <bool I8> struct AccT { typedef f32x4 type; };
template <> struct AccT<true> { typedef i32x4 type; };
__device__ __forceinline__ f32x4 mma16(bf16x8 a, bf16x8 b, f32x4 c) { return __builtin_amdgcn_mfma_f32_16x16x32_bf16(a, b, c, 0, 0, 0); }
__device__ __forceinline__ i32x4 mma16(bf16x8 a, bf16x8 b, i32x4 c) { return __builtin_amdgcn_mfma_i32_16x16x64_i8(__builtin_bit_cast(i32x4, a), __builtin_bit_cast(i32x4, b), c, 0, 0, 0); }
struct Unit { int pm, pn, kb, nt, part, lpm, lpn; };
struct Gemm { const bf16_t* A; const bf16_t* Bt; int M, N, K; };
struct StaticOrder {
    int nM, nN, nwg, G, c, ntf, hot = 0;
    __device__ void init(int M, int N, int K, int G_, int c_) { nM = M / BM; nN = N / BM; nwg = nM * nN; G = G_; c = c_; ntf = K / BK; }
    __device__ __forceinline__ void tile(int wgid, int& pm, int& pn) const {
        { const int q = nwg / NXCD, r = nwg % NXCD, xcd = wgid % NXCD, off = wgid / NXCD; wgid = (xcd < r ? xcd * (q + 1) : r * (q + 1) + (xcd - r) * q) + off; }
        const int nig = WGM * nN, gid = wgid / nig, fm = gid * WGM, gsz = (nM - fm) < WGM ? (nM - fm) : WGM;
        pm = fm + ((wgid % nig) % gsz); pn = (wgid % nig) / gsz; }
    __device__ bool next(int i, Unit& u) const {
        const long L = (long)i * G + c; if (L >= nwg) return false;
        int pm, pn; tile((int)L, pm, pn);
        u.pm = pm; u.pn = pn; u.kb = 0; u.nt = ntf; u.part = -1; u.lpm = hot ? 0 : pm; u.lpn = hot ? 0 : pn; return true;
    }
    __device__ __forceinline__ void a_ready(const Unit&) const {}
    __device__ __forceinline__ void done(const Unit&) const {}
};
struct TailSplitOrder {
    StaticOrder base; int nsp, K;
    __device__ void init(int M, int N, int K_, int nsp_, int G_, int c_) { base.init(M, N, K_, G_, c_); nsp = nsp_; K = K_; }
    __device__ bool next(int i, Unit& u) const {
        const long L = (long)i * base.G + base.c; const int s = (int)(L - base.nwg);
        if (L >= base.nwg && s >= nsp * base.nN * 4) return false;
        int pm, pn, kb = 0, nt = base.ntf, part = -1;
        if (L < base.nwg) base.tile((int)L, pm, pn);
        else { const int kq = s & 3, t = s >> 2; pn = t % base.nN; pm = base.nM + t / base.nN; kb = kq * (K / 4) * 2; nt = K / 4 / BK; part = kq; }
        u.pm = pm; u.pn = pn; u.kb = kb; u.nt = nt; u.part = part; u.lpm = pm; u.lpn = pn; return true;
    }
    __device__ __forceinline__ void a_ready(const Unit&) const {}
    __device__ __forceinline__ void done(const Unit&) const {}
};
struct TailTilesOrder {
    StaticOrder base; int ntail, tw, tc0;
    __device__ void init(int M, int N, int K_, int ntail_, int tw_, int tc0_, int G_, int c_) { base.init(M, N, K_, G_, c_); ntail = ntail_; tw = tw_; tc0 = tc0_; }
    __device__ bool next(int i, Unit& u) const {
        const long L = (long)i * base.G + base.c; const int s = (int)(L - base.nwg);
        if (L >= base.nwg && s >= ntail) return false;
        int pm, pn;
        if (L < base.nwg) base.tile((int)L, pm, pn); else { pm = base.nM + s / tw; pn = tc0 + s % tw; }
        u.pm = pm; u.pn = pn; u.kb = 0; u.nt = base.ntf; u.part = -1; u.lpm = pm; u.lpn = pn; return true;
    }
    __device__ __forceinline__ void a_ready(const Unit&) const {}
    __device__ __forceinline__ void done(const Unit&) const {}
};
typedef __bf16 bf16v2_t __attribute__((ext_vector_type(2)));
typedef float f32x2_t __attribute__((ext_vector_type(2)));
__device__ __forceinline__ unsigned cvt_pk_bf16(float lo, float hi) { f32x2_t v = {lo, hi}; bf16v2_t r = __builtin_convertvector(v, bf16v2_t); return __builtin_bit_cast(unsigned, r); }

struct EpiF32 {
    static constexpr bool PERM = false, AFTER_DRAIN = false, I8 = false;
    float* C; int ldc;
    __device__ __forceinline__ void operator()(const f32x4 (&acc)[2][2][4][2], const Unit& u, int wr, int wc, int fr, int fq) const {
        const int row0 = u.pm * BM + wr * 64 + fr, col0 = u.pn * BM + wc * 32 + 4 * fq;
#pragma unroll
        for (int ai = 0; ai < 2; ++ai)
#pragma unroll
            for (int m = 0; m < 4; ++m) { float* rowp = C + (size_t)(row0 + ai * HALF + m * 16) * ldc + col0;
#pragma unroll
                for (int bj = 0; bj < 2; ++bj)
#pragma unroll
                    for (int n = 0; n < 2; ++n) *(f32x4*)(rowp + bj * HALF + n * 16) = acc[ai][bj][m][n]; }
    }
};
template <int ACT> struct EpiBf16 {
    static constexpr bool PERM = true, AFTER_DRAIN = false, I8 = false;
    bf16_t* O; int ldc; float* gates; int gate_pn; bf16_t* QKV; int mt;
    __device__ __forceinline__ void operator()(const f32x4 (&acc)[2][2][4][2], const Unit& u, int wr, int wc, int fr, int fq) const {
        const int row0 = u.pm * BM + wr * 64 + fr;
        const bool gt = (ACT == 0) && (u.pn == gate_pn) && (wc == 0);
        const bool hm = (ACT == 0) && (u.pn >= 4) && (u.pn < 16);
        bf16_t* base; size_t rstride, bstride;
        if (hm) { base = QKV + ((size_t)((u.pn - 4) * 2) * mt + row0) * 128 + wc * 32 + 8 * fq; rstride = 128; bstride = (size_t)mt * 128; }
        else { const int colt = (ACT == 0) ? ((u.pn < 4 ? u.pn : u.pn - 12) * BM) : u.pn * BM; base = O + (size_t)row0 * ldc + colt + wc * 32 + 8 * fq; rstride = (size_t)ldc; bstride = HALF; }
#pragma unroll
        for (int ai = 0; ai < 2; ++ai)
#pragma unroll
            for (int m = 0; m < 4; ++m) { bf16_t* rowp = base + (size_t)(ai * HALF + m * 16) * rstride;
#pragma unroll
                for (int bj = 0; bj < 2; ++bj) { f32x4 v0 = acc[ai][bj][m][0], v1 = acc[ai][bj][m][1];
                    if (ACT == 1) {
#pragma unroll
                        for (int j = 0; j < 4; ++j) { float a0 = fmaxf(v0[j], 0.f), a1 = fmaxf(v1[j], 0.f); v0[j] = a0 * a0; v1[j] = a1 * a1; } }
                    if (ACT == 0 && bj == 0 && gt) { float* gp = gates + (size_t)(row0 + ai * HALF + m * 16) * 32 + 8 * fq; *(f32x4*)gp = v0; *(f32x4*)(gp + 4) = v1; }
                    u32x4 w; w.x = cvt_pk_bf16(v0[0], v0[1]); w.y = cvt_pk_bf16(v0[2], v0[3]); w.z = cvt_pk_bf16(v1[0], v1[1]); w.w = cvt_pk_bf16(v1[2], v1[3]);
                    *(u32x4*)(rowp + bj * bstride) = w; } }
    }
};
struct EpiY {
    static constexpr bool PERM = true, AFTER_DRAIN = false, I8 = false;
    bf16_t* O; int ldc; bf16_t* P; int row0; size_t pstride;
    __device__ __forceinline__ void operator()(const f32x4 (&acc)[2][2][4][2], const Unit& u, int wr, int wc, int fr, int fq) const {
        const int row0_ = u.pm * BM + wr * 64 + fr, col0 = u.pn * BM + wc * 32 + 8 * fq;
        if (u.part < 0) {
#pragma unroll
            for (int ai = 0; ai < 2; ++ai)
#pragma unroll
                for (int m = 0; m < 4; ++m) { bf16_t* rowp = O + (size_t)(row0_ + ai * HALF + m * 16) * ldc + col0;
#pragma unroll
                    for (int bj = 0; bj < 2; ++bj) { const f32x4 v0 = acc[ai][bj][m][0], v1 = acc[ai][bj][m][1];
                        u32x4 w; w.x = cvt_pk_bf16(v0[0], v0[1]); w.y = cvt_pk_bf16(v0[2], v0[3]); w.z = cvt_pk_bf16(v1[0], v1[1]); w.w = cvt_pk_bf16(v1[2], v1[3]);
                        *(u32x4*)(rowp + bj * HALF) = w; } }
        } else {
            bf16_t* base = P + (size_t)u.part * pstride;
#pragma unroll
            for (int ai = 0; ai < 2; ++ai)
#pragma unroll
                for (int m = 0; m < 4; ++m) { bf16_t* rowp = base + (size_t)(row0_ - row0 + ai * HALF + m * 16) * ldc + col0;
#pragma unroll
                    for (int bj = 0; bj < 2; ++bj) { const f32x4 v0 = acc[ai][bj][m][0], v1 = acc[ai][bj][m][1];
                        u32x4 w; w.x = cvt_pk_bf16(v0[0], v0[1]); w.y = cvt_pk_bf16(v0[2], v0[3]); w.z = cvt_pk_bf16(v1[0], v1[1]); w.w = cvt_pk_bf16(v1[2], v1[3]);
                        *(u32x4*)(rowp + bj * HALF) = w; } }
        }
    }
};
struct EpiProjI8 {
    static constexpr bool PERM = true, AFTER_DRAIN = false, I8 = true;
    bf16_t* O; int ldc; float* gates; int gate_pn; bf16_t* QKV; int mt; const float* rs; const float* cs;
    __device__ __forceinline__ void operator()(const i32x4 (&acc)[2][2][4][2], const Unit& u, int wr, int wc, int fr, int fq) const {
        const int row0 = u.pm * BM + wr * 64 + fr;
        const bool gt = (u.pn == gate_pn) && (wc == 0);
        const bool hm = (u.pn >= 4) && (u.pn < 16);
        bf16_t* base; size_t rstride, bstride;
        if (hm) { base = QKV + ((size_t)((u.pn - 4) * 2) * mt + row0) * 128 + wc * 32 + 8 * fq; rstride = 128; bstride = (size_t)mt * 128; }
        else { const int colt = (u.pn < 4 ? u.pn : u.pn - 12) * BM; base = O + (size_t)row0 * ldc + colt + wc * 32 + 8 * fq; rstride = (size_t)ldc; bstride = HALF; }
        f32x4 cv[2][2];
#pragma unroll
        for (int bj = 0; bj < 2; ++bj)
#pragma unroll
            for (int n = 0; n < 2; ++n) cv[bj][n] = *(const f32x4*)(cs + u.pn * BM + bj * HALF + wc * 32 + 8 * fq + 4 * n);
#pragma unroll
        for (int ai = 0; ai < 2; ++ai)
#pragma unroll
            for (int m = 0; m < 4; ++m) { const int row = row0 + ai * HALF + m * 16; bf16_t* rowp = base + (size_t)(ai * HALF + m * 16) * rstride; const float r = rs[row];
#pragma unroll
                for (int bj = 0; bj < 2; ++bj) { const i32x4 a0 = acc[ai][bj][m][0], a1 = acc[ai][bj][m][1];
                    const f32x4 v0 = (f32x4){(float)a0[0], (float)a0[1], (float)a0[2], (float)a0[3]} * cv[bj][0] * r, v1 = (f32x4){(float)a1[0], (float)a1[1], (float)a1[2], (float)a1[3]} * cv[bj][1] * r;
                    if (bj == 0 && gt) { float* gp = gates + (size_t)row * 32 + 8 * fq; *(f32x4*)gp = v0; *(f32x4*)(gp + 4) = v1; }
                    u32x4 w; w.x = cvt_pk_bf16(v0[0], v0[1]); w.y = cvt_pk_bf16(v0[2], v0[3]); w.z = cvt_pk_bf16(v1[0], v1[1]); w.w = cvt_pk_bf16(v1[2], v1[3]);
                    *(u32x4*)(rowp + bj * bstride) = w; } }
    }
};
struct EpiSqReluI8 {
    static constexpr bool PERM = true, AFTER_DRAIN = false, I8 = true;
    bf16_t* O; int ldc; const float* rs; const float* cs;
    __device__ __forceinline__ void operator()(const i32x4 (&acc)[2][2][4][2], const Unit& u, int wr, int wc, int fr, int fq) const {
        const int row0 = u.pm * BM + wr * 64 + fr, col0 = u.pn * BM + wc * 32 + 8 * fq;
        f32x4 cv[2][2];
#pragma unroll
        for (int bj = 0; bj < 2; ++bj)
#pragma unroll
            for (int n = 0; n < 2; ++n) cv[bj][n] = *(const f32x4*)(cs + col0 + bj * HALF + 4 * n);
#pragma unroll
        for (int ai = 0; ai < 2; ++ai)
#pragma unroll
            for (int m = 0; m < 4; ++m) { const int row = row0 + ai * HALF + m * 16; bf16_t* rowp = O + (size_t)row * ldc + col0; const float r = rs[row];
#pragma unroll
                for (int bj = 0; bj < 2; ++bj) { const i32x4 a0 = acc[ai][bj][m][0], a1 = acc[ai][bj][m][1];
                    f32x4 v0 = (f32x4){(float)a0[0], (float)a0[1], (float)a0[2], (float)a0[3]} * cv[bj][0] * r, v1 = (f32x4){(float)a1[0], (float)a1[1], (float)a1[2], (float)a1[3]} * cv[bj][1] * r;
#pragma unroll
                    for (int j = 0; j < 4; ++j) { const float b0 = fmaxf(v0[j], 0.f), b1 = fmaxf(v1[j], 0.f); v0[j] = b0 * b0; v1[j] = b1 * b1; }
                    u32x4 w; w.x = cvt_pk_bf16(v0[0], v0[1]); w.y = cvt_pk_bf16(v0[2], v0[3]); w.z = cvt_pk_bf16(v1[0], v1[1]); w.w = cvt_pk_bf16(v1[2], v1[3]);
                    *(u32x4*)(rowp + bj * HALF) = w; } }
    }
};

template <class Epi, class Sched, bool ALIGN_EPI = true, bool SP2 = true>
__device__ __forceinline__ void gemm_phase(PG8_LAS unsigned char* lds, const Gemm g, const Sched& S, const Epi& E) {
    int tid = threadIdx.x; asm volatile("" : "+v"(tid));
    const int wid = __builtin_amdgcn_readfirstlane(tid >> 6), lane = tid & 63, wr = wid >> 2, wc = wid & 3, fr = lane & 15, fq = lane >> 4;
    const int K = g.K;
    unsigned voffA[2], voffB[2];
#pragma unroll
    for (int i = 0; i < 2; ++i) { int R, C; stage_rc(tid * 16 + i * 8192, R, C); const int Rb = Epi::PERM ? ((R & ~31) + perm32(R & 31)) : R;
        voffA[i] = (unsigned)(R * K + C) * 2u; voffB[i] = (unsigned)(Rb * K + C) * 2u; }
    const size_t kstep = (size_t)(BK * 2);
    const size_t hstep = (size_t)HALF * K * 2;
    const size_t tstep = 2 * hstep;
    const unsigned ldsw = (unsigned)wid * 1024u;
    const int aoff = lds_byte(wr * 64 + fr, fq * 8), boff = lds_byte(wc * 32 + fr, fq * 8);
#define PG8_SA(b, h) (((b) * 2 + (h)) * HTB)
#define PG8_SB(b, h) ((4 + (b) * 2 + (h)) * HTB)
#define PG8_STAGE(bufoff, gbase, voff) do { _Pragma("unroll") for (int _i = 0; _i < 2; ++_i) \
        __builtin_amdgcn_global_load_lds((const unsigned*)((const char*)(gbase) + (voff)[_i]), (PG8_LAS unsigned*)(lds + (bufoff) + ldsw + _i * 8192), 16, 0, 0); } while (0)
#define PG8_LDA(dst, b, h) do { _Pragma("unroll") for (int m = 0; m < 4; ++m) _Pragma("unroll") for (int k = 0; k < 2; ++k) dst[m][k] = *(const PG8_LAS bf16x8*)(lds + PG8_SA(b, h) + aoff + m * 2048 + k * 1024); } while (0)
#define PG8_LDB(dst, b, h) do { _Pragma("unroll") for (int n = 0; n < 2; ++n) _Pragma("unroll") for (int k = 0; k < 2; ++k) dst[n][k] = *(const PG8_LAS bf16x8*)(lds + PG8_SB(b, h) + boff + n * 2048 + k * 1024); } while (0)
#define PG8_MMA(ai, bj, At, Bt) do { __builtin_amdgcn_s_setprio(1); _Pragma("unroll") for (int m = 0; m < 4; ++m) _Pragma("unroll") for (int n = 0; n < 2; ++n) _Pragma("unroll") for (int k = 0; k < 2; ++k) \
        acc[ai][bj][m][n] = mma16(Bt[n][k], At[m][k], acc[ai][bj][m][n]); __builtin_amdgcn_s_setprio(0); } while (0)
#define PG8_WAIT_V(n) asm volatile("s_waitcnt vmcnt(" #n ")" ::: "memory")
#define PG8_WAIT_L(n) asm volatile("s_waitcnt lgkmcnt(" #n ")" ::: "memory")
#define PG8_BAR __builtin_amdgcn_s_barrier()
#define PG8_SCHED __builtin_amdgcn_sched_barrier(0)
    Unit cur, nxt; int ui = 0;
    if (!S.next(0, cur)) return;
    typedef typename AccT<Epi::I8>::type acc_t;
    acc_t acc[2][2][4][2];
#pragma unroll
    for (int a = 0; a < 2; ++a)
#pragma unroll
        for (int b = 0; b < 2; ++b)
#pragma unroll
            for (int m = 0; m < 4; ++m)
#pragma unroll
                for (int n = 0; n < 2; ++n) acc[a][b][m][n] = (acc_t){0, 0, 0, 0};
    bf16x8 At[4][2], B0[2][2], B1[2][2];
    const char* cA = (const char*)g.A + (size_t)cur.lpm * tstep + cur.kb; const char* cB = (const char*)g.Bt + (size_t)cur.lpn * tstep + cur.kb;
    S.a_ready(cur);
    if constexpr (SP2) {
        PG8_STAGE(PG8_SB(0, 0), cB, voffB); PG8_STAGE(PG8_SB(0, 1), cB + hstep, voffB); PG8_STAGE(PG8_SA(0, 0), cA, voffA); PG8_STAGE(PG8_SA(0, 1), cA + hstep, voffA);
        if (wr == 1) PG8_BAR;
        PG8_WAIT_V(2); PG8_BAR;
        PG8_STAGE(PG8_SB(1, 0), cB + kstep, voffB); PG8_STAGE(PG8_SA(1, 0), cA + kstep, voffA); PG8_STAGE(PG8_SB(1, 1), cB + hstep + kstep, voffB);
        PG8_WAIT_V(6); PG8_BAR;
    } else {
        PG8_STAGE(PG8_SB(0, 0), cB, voffB); PG8_STAGE(PG8_SA(0, 0), cA, voffA); PG8_STAGE(PG8_SB(0, 1), cB + hstep, voffB); PG8_STAGE(PG8_SA(0, 1), cA + hstep, voffA);
        if (wr == 1) PG8_BAR;
        PG8_WAIT_V(4); PG8_BAR;
        PG8_STAGE(PG8_SB(1, 0), cB + kstep, voffB); PG8_STAGE(PG8_SA(1, 0), cA + kstep, voffA); PG8_STAGE(PG8_SB(1, 1), cB + hstep + kstep, voffB);
        PG8_WAIT_V(6); PG8_BAR;
    }
    for (;;) {
        const bool has_next = S.next(ui + 1, nxt);
        const char* nA = has_next ? (const char*)g.A + (size_t)nxt.lpm * tstep + nxt.kb : cA; const char* nB = has_next ? (const char*)g.Bt + (size_t)nxt.lpn * tstep + nxt.kb : cB;
        const int nt = cur.nt;
        for (int t = 0; t < nt; t += 2) {
            const bool last = (t == nt - 2);
            const char* a1 = cA + (size_t)(t + 1) * kstep;
            const char* a2 = last ? nA : cA + (size_t)(t + 2) * kstep; const char* b2 = last ? nB : cB + (size_t)(t + 2) * kstep;
            const char* a3 = a2 + kstep; const char* b3 = b2 + kstep;
            if (last && has_next) S.a_ready(nxt);
            if constexpr (SP2) {
            PG8_LDB(B0, 0, 0); PG8_LDB(B1, 0, 1); PG8_SCHED; PG8_LDA(At, 0, 0); PG8_STAGE(PG8_SA(1, 1), a1 + hstep, voffA);
            PG8_WAIT_V(8); PG8_WAIT_L(0); PG8_BAR; PG8_MMA(0, 0, At, B0); PG8_MMA(0, 1, At, B1); PG8_BAR; PG8_SCHED;
            PG8_LDA(At, 0, 1); PG8_STAGE(PG8_SB(0, 0), b2, voffB); PG8_STAGE(PG8_SB(0, 1), b2 + hstep, voffB); PG8_STAGE(PG8_SA(0, 0), a2, voffA);
            PG8_WAIT_V(8); PG8_WAIT_L(0); PG8_BAR; PG8_MMA(1, 0, At, B0); PG8_MMA(1, 1, At, B1); PG8_BAR; PG8_SCHED;
            PG8_LDB(B0, 1, 0); PG8_LDB(B1, 1, 1); PG8_SCHED; PG8_LDA(At, 1, 0); PG8_STAGE(PG8_SA(0, 1), a2 + hstep, voffA);
            PG8_WAIT_V(8); PG8_WAIT_L(0); PG8_BAR; PG8_MMA(0, 0, At, B0); PG8_MMA(0, 1, At, B1); PG8_BAR; PG8_SCHED;
            PG8_LDA(At, 1, 1); PG8_STAGE(PG8_SB(1, 0), b3, voffB); PG8_STAGE(PG8_SB(1, 1), b3 + hstep, voffB); PG8_STAGE(PG8_SA(1, 0), a3, voffA);
            PG8_WAIT_V(8); PG8_WAIT_L(0); PG8_BAR; PG8_MMA(1, 0, At, B0); PG8_MMA(1, 1, At, B1); PG8_BAR; PG8_SCHED;
            } else {
            PG8_LDB(B0, 0, 0); PG8_SCHED; PG8_LDA(At, 0, 0); PG8_STAGE(PG8_SA(1, 1), a1 + hstep, voffA);
            PG8_WAIT_L(8); PG8_BAR; PG8_WAIT_L(0); PG8_MMA(0, 0, At, B0); PG8_BAR; PG8_SCHED;
            PG8_LDB(B1, 0, 1); PG8_STAGE(PG8_SB(0, 0), b2, voffB);
            PG8_BAR; PG8_WAIT_L(0); PG8_MMA(0, 1, At, B1); PG8_BAR;
            PG8_LDA(At, 0, 1); PG8_STAGE(PG8_SA(0, 0), a2, voffA);
            PG8_BAR; PG8_WAIT_L(0); PG8_MMA(1, 0, At, B0); PG8_BAR; PG8_SCHED;
            PG8_STAGE(PG8_SB(0, 1), b2 + hstep, voffB);
            PG8_WAIT_V(6); PG8_BAR; PG8_MMA(1, 1, At, B1); PG8_BAR;
            PG8_LDB(B0, 1, 0); PG8_SCHED; PG8_LDA(At, 1, 0); PG8_STAGE(PG8_SA(0, 1), a2 + hstep, voffA);
            PG8_WAIT_L(8); PG8_BAR; PG8_WAIT_L(0); PG8_MMA(0, 0, At, B0); PG8_BAR; PG8_SCHED;
            PG8_LDB(B1, 1, 1); PG8_STAGE(PG8_SB(1, 0), b3, voffB);
            PG8_BAR; PG8_WAIT_L(0); PG8_MMA(0, 1, At, B1); PG8_BAR;
            PG8_LDA(At, 1, 1); PG8_STAGE(PG8_SA(1, 0), a3, voffA);
            PG8_BAR; PG8_WAIT_L(0); PG8_MMA(1, 0, At, B0); PG8_BAR; PG8_SCHED;
            PG8_STAGE(PG8_SB(1, 1), b3 + hstep, voffB);
            PG8_WAIT_V(6); PG8_BAR; PG8_MMA(1, 1, At, B1); PG8_BAR;
            }
        }
        if constexpr (ALIGN_EPI) { if (wr == 0) PG8_BAR; }
        if constexpr (!Epi::AFTER_DRAIN) { for (int re_ = 0; re_ <= REP_EPI; ++re_) E(acc, cur, wr, wc, fr, fq); S.done(cur); }
        if (!has_next) break;
#pragma unroll
        for (int a = 0; a < 2; ++a)
#pragma unroll
            for (int b = 0; b < 2; ++b)
#pragma unroll
                for (int m = 0; m < 4; ++m)
#pragma unroll
                    for (int n = 0; n < 2; ++n) acc[a][b][m][n] = (acc_t){0, 0, 0, 0};
        cur = nxt; cA = nA; cB = nB; ++ui;
        if constexpr (ALIGN_EPI) { if (wr == 1) PG8_BAR; }
    }
    PG8_WAIT_V(0);
    if constexpr (!ALIGN_EPI) { if (wr == 0) PG8_BAR; }
    PG8_BAR;
    if constexpr (Epi::AFTER_DRAIN) { E.fused(acc, cur, wr, wc, fr, fq, lds, wid, lane); S.done(cur); }
#undef PG8_SA
#undef PG8_SB
#undef PG8_STAGE
#undef PG8_LDA
#undef PG8_LDB
#undef PG8_MMA
#undef PG8_WAIT_V
#undef PG8_WAIT_L
#undef PG8_BAR
#undef PG8_SCHED
}
}
using pg8::bf16_t; using pg8::bf16x8; using pg8::f32x4; using pg8::u32x4;
#define LAS __attribute__((address_space(3)))
typedef short s16x4 __attribute__((ext_vector_type(4)));
typedef unsigned u32x2 __attribute__((ext_vector_type(2)));

constexpr int D = 2048, NB = 8, SEQ = 2048, DEPTH = 2, CTXL = 256, DCONV = 512, DML = 1024, NH = 8, DH = 128, KA = 31, DFF = 8192;
constexpr int DIN = 6688, DINP = 6912, MX = NB * SEQ, MC = NB * CTXL, MT = MX + MC;
constexpr int C_AVAL = 0, C_AGATE = 512, C_Q = 1024, C_K = 2048, C_V = 3072, C_O = 4096, C_G = 5120, C_SIN = 5152, C_SB = 5664, C_SC = 6176;
constexpr int DP = DINP - 3 * DML, P_AVAL = 0, P_AGATE = 512, P_O = C_O - 3 * DML, P_SIN = C_SIN - 3 * DML, P_SB = C_SB - 3 * DML, P_SC = C_SC - 3 * DML;
constexpr float EPS = 1e-6f;
constexpr int LDS_BYTES = 131072 + 16, LDS_BARST = 131072;
constexpr size_t SZ_WIN = (size_t)DINP * D * 2, SZ_WOUT = (size_t)D * D * 2, SZ_WFF = (size_t)DFF * D * 2, SZ_WL = SZ_WIN + SZ_WOUT + 2 * SZ_WFF;
constexpr size_t WS_W = 0, WS_XB = WS_W + SZ_WL, WS_HX = WS_XB + (size_t)MT * D * 2, WS_PROJ = WS_HX + (size_t)MT * D * 2, WS_QKVH = WS_PROJ + (size_t)MT * DP * 2, WS_MIX = WS_PROJ + (size_t)MT * DINP * 2,
                 WS_Y = WS_MIX + (size_t)MT * D * 2, WS_YP = WS_Y + (size_t)MT * D * 2, WS_GATES = WS_Y + (size_t)MT * D * 4, WS_CTX = WS_GATES + (size_t)MT * 32 * 4,
                 WS_MOD = WS_CTX + (size_t)MC * D * 4, WS_BAR = WS_MOD + (size_t)DEPTH * 9 * 6 * D * 4, WS_CMAX = WS_BAR + 16384, WS_CSC = WS_CMAX + (size_t)DEPTH * DFF * 4, WS_RSC = WS_CSC + (size_t)DEPTH * DFF * 4, WS_END = WS_RSC + (size_t)MT * 4;
static_assert((size_t)MT * DFF * 2 <= WS_Y - WS_PROJ, "H1 aliases PROJ+MIX");

struct Args { const float* in[21]; float* out; unsigned char* ws; int ph_lo, ph_hi; };
enum { I_X = 0, I_C, I_CTX, I_CCTX, I_WADA, I_BADA, I_GPREMIX, I_GPOSTMIX, I_GPREFFN, I_GPOSTFFN, I_WIN, I_BGATES, I_CAW, I_CAB, I_LNAW, I_LNAB, I_MNW, I_CCW, I_WOUT, I_WFF1, I_WFF2 };

__device__ __forceinline__ int otid() { int t = threadIdx.x; asm volatile("" : "+v"(t)); return t; }
__device__ __forceinline__ float wave_sum(float v) {
#pragma unroll
    for (int o = 32; o; o >>= 1) v += __shfl_xor(v, o);
    return v; }
__device__ __forceinline__ float bf2f(unsigned short h) { return __uint_as_float(((unsigned)h) << 16); }
__device__ __forceinline__ float bflo(unsigned w) { return __uint_as_float(w << 16); }
__device__ __forceinline__ float bfhi(unsigned w) { return __uint_as_float(w & 0xffff0000u); }
__device__ __forceinline__ unsigned short f2bf(float f) { return (unsigned short)(pg8::cvt_pk_bf16(f, 0.f) & 0xffffu); }
__device__ __forceinline__ float sigmoidf_(float x) { return __builtin_amdgcn_rcpf(1.f + __expf(-x)); }

#define XB_TMO      128
#define XB_XCNT(j)  (256  + 64 * (j))
#define XB_XSUB(j)  (1280 + 64 * (j))
#define XB_XGEN(j)  (2304 + 64 * (j))
#define XB_TOP      3328
#define XB_TOPGEN   3392
#define XCD_BAR_WORDS 3456
#define XB_SPIN_CAP (1u << 18)

__device__ __forceinline__ unsigned xb_ld(unsigned* p)              { return __hip_atomic_load(p, __ATOMIC_RELAXED, __HIP_MEMORY_SCOPE_AGENT); }
__device__ __forceinline__ unsigned xb_add(unsigned* p, unsigned v) { return __hip_atomic_fetch_add(p, v, __ATOMIC_RELAXED, __HIP_MEMORY_SCOPE_AGENT); }
__device__ __forceinline__ unsigned xb_xcc_id() { return (unsigned)__builtin_amdgcn_s_getreg((3 << 11) | 20) & 0xFu; }
#define XB_SPIN(cond, bar) do { unsigned _sp = 0; while (cond) { __builtin_amdgcn_s_sleep(1); \
    if ((++_sp & 255u) == 0u) { if (xb_ld(&(bar)[XB_TMO])) break; if (_sp > XB_SPIN_CAP) { atomicAdd(&(bar)[XB_TMO], 1u); break; } } } } while (0)

struct XcdBarrier {
    unsigned* bar; unsigned x;
    volatile LAS unsigned* st;
};

__device__ __forceinline__ XcdBarrier xcd_barrier_post(unsigned* bar, volatile LAS unsigned* st) {
    XcdBarrier b; b.bar = bar; b.x = xb_xcc_id(); b.st = st;
    if (threadIdx.x == 0) (void)xb_add(&bar[XB_XCNT(b.x)], 1u);
    return b;
}
__device__ __forceinline__ void xcd_barrier_complete(unsigned* bar, unsigned x, unsigned& nloc, unsigned& nx) {
    const unsigned G = gridDim.x * gridDim.y * gridDim.z;
    unsigned sum, cnt, mine, sp = 0u;
    for (;;) {
        sum = 0u; cnt = 0u; mine = 0u;
#pragma unroll
        for (unsigned j = 0; j < 16; ++j) { const unsigned c = xb_ld(&bar[XB_XCNT(j)]); sum += c; cnt += (c > 0u) ? 1u : 0u; mine = (j == x) ? c : mine; }
        if (sum == G) break;
        __builtin_amdgcn_s_sleep(1);
        if ((++sp & 255u) == 0u) { if (xb_ld(&bar[XB_TMO])) break; if (sp > XB_SPIN_CAP) { atomicAdd(&bar[XB_TMO], 1u); break; } }
    }
    nloc = mine > 0u ? mine : 1u; nx = cnt > 0u ? cnt : 1u;
}

__device__ __forceinline__ void xcd_barrier(const XcdBarrier& b) {
    asm volatile("s_waitcnt vmcnt(0)" ::: "memory");
    __syncthreads();
    if (threadIdx.x == 0) {
        unsigned* bar; { const unsigned long long bp_ = (unsigned long long)b.bar; unsigned lo_ = __builtin_amdgcn_readfirstlane((unsigned)bp_), hi_ = __builtin_amdgcn_readfirstlane((unsigned)(bp_ >> 32)); asm volatile("" : "+s"(lo_), "+s"(hi_)); bar = (unsigned*)(((unsigned long long)hi_ << 32) | lo_); } unsigned bx = __builtin_amdgcn_readfirstlane(b.x); asm volatile("" : "+s"(bx));
        __builtin_amdgcn_s_waitcnt(0);
        unsigned nloc = b.st[0], nx = b.st[1];
        if (nloc == 0u) { xcd_barrier_complete(bar, bx, nloc, nx); b.st[0] = nloc; b.st[1] = nx; }
        const unsigned old = xb_add(&bar[XB_XSUB(bx)], 1u);
        const unsigned gen = old / nloc;
        if (old + 1u == (gen + 1u) * nloc) {
            __builtin_amdgcn_fence(__ATOMIC_RELEASE, "agent");
            asm volatile("s_waitcnt vmcnt(0)" ::: "memory");
            const unsigned og = xb_add(&bar[XB_TOP], 1u);
            const unsigned tg = og / nx;
            if (og + 1u == (tg + 1u) * nx) xb_add(&bar[XB_TOPGEN], 1u);
            else XB_SPIN(xb_ld(&bar[XB_TOPGEN]) == tg, bar);
            __builtin_amdgcn_fence(__ATOMIC_ACQUIRE, "agent");
            xb_add(&bar[XB_XGEN(bx)], 1u);
            asm volatile("s_waitcnt vmcnt(0)" ::: "memory");
        } else {
            XB_SPIN(xb_ld(&bar[XB_XGEN(bx)]) == gen, bar);
            __builtin_amdgcn_fence(__ATOMIC_ACQUIRE, "agent");
            asm volatile("s_waitcnt vmcnt(0)" ::: "memory");
        }
    }
    __syncthreads();
}


#define LDS_BARRIER() do { asm volatile("s_waitcnt lgkmcnt(0)" ::: "memory"); __builtin_amdgcn_s_barrier(); asm volatile("" ::: "memory"); } while (0)
__device__ void convert_matrix(const float* __restrict__ W, int K, int N, int Npad, bf16_t* __restrict__ Wt, int klo, int khi, LAS float* t, const float* cmax, float* csc) {
    constexpr int CVT = 4;
    const int tid = otid(), ntk = K / 64, ntn = Npad / 64, ntiles = ntk * ntn, G = gridDim.x;
    const int kr0 = tid >> 4, c4 = tid & 15;
    f32x4 cur[CVT][2], nx[CVT][2];
#define CV_LOAD(dst, it_) do { _Pragma("unroll") for (int p_ = 0; p_ < CVT; ++p_) { const int itp_ = (it_) + p_ * G; const int tk_ = itp_ / ntn, tn_ = itp_ % ntn, n_ = tn_ * 64 + c4 * 4; \
        _Pragma("unroll") for (int i_ = 0; i_ < 2; ++i_) { dst[p_][i_] = (f32x4){0.f, 0.f, 0.f, 0.f}; \
            if (itp_ < ntiles && n_ < N) dst[p_][i_] = *(const f32x4*)(W + (size_t)(tk_ * 64 + kr0 + 32 * i_) * N + n_); } } } while (0)
    int it = blockIdx.x;
    if (it < ntiles) CV_LOAD(cur, it);
    for (; it < ntiles; it += CVT * G) {
        if (it + CVT * G < ntiles) CV_LOAD(nx, it + CVT * G);
#pragma unroll
        for (int p = 0; p < CVT; ++p)
#pragma unroll
            for (int i = 0; i < 2; ++i) { LAS float* tp = t + p * 64 * 65 + (kr0 + 32 * i) * 65 + c4 * 4; tp[0] = cur[p][i][0]; tp[1] = cur[p][i][1]; tp[2] = cur[p][i][2]; tp[3] = cur[p][i][3]; }
        LDS_BARRIER();
#pragma unroll
        for (int p = 0; p < CVT; ++p) { const int itp = it + p * G;
            if (itp < ntiles) { const int tk = itp / ntn, tn = itp % ntn, nl = tid >> 3, ks = (tid & 7) * 8, n = tn * 64 + nl; const float sc = (n >= klo && n < khi) ? 0.08838834764831845f : 1.f;
                float v[8];
                if (cmax) {
                    const float cm = cmax[n], inv = cm > 0.f ? 127.f / cm : 0.f;
#pragma unroll
                    for (int i = 0; i < 8; ++i) v[i] = t[p * 64 * 65 + (ks + i) * 65 + nl] * inv;
                    unsigned q[8];
#pragma unroll
                    for (int i = 0; i < 8; ++i) q[i] = (unsigned)(int)__builtin_rintf(v[i]) & 0xffu;
                    u32x2 w; w.x = q[0] | (q[1] << 8) | (q[2] << 16) | (q[3] << 24); w.y = q[4] | (q[5] << 8) | (q[6] << 16) | (q[7] << 24);
                    *(u32x2*)((unsigned char*)Wt + (size_t)n * K + tk * 64 + ks) = w;
                    if (tk == 0 && ks == 0) csc[n] = cm * (1.f / 127.f) * sc;
                } else {
#pragma unroll
                for (int i = 0; i < 8; ++i) v[i] = t[p * 64 * 65 + (ks + i) * 65 + nl] * sc;
                u32x4 w; w.x = pg8::cvt_pk_bf16(v[0], v[1]); w.y = pg8::cvt_pk_bf16(v[2], v[3]); w.z = pg8::cvt_pk_bf16(v[4], v[5]); w.w = pg8::cvt_pk_bf16(v[6], v[7]);
                *(u32x4*)(Wt + (size_t)n * K + tk * 64 + ks) = w; } } }
        LDS_BARRIER();
#pragma unroll
        for (int p = 0; p < CVT; ++p)
#pragma unroll
            for (int i = 0; i < 2; ++i) cur[p][i] = nx[p][i];
    }
#undef CV_LOAD
    __syncthreads();
}
__device__ void colmax_phase(const Args& a, LAS float* red) {
    const int tid = otid(), lane = tid & 63, wv = tid >> 6, cgp = tid & 15, kq = tid >> 4;
    float* CM = (float*)(a.ws + WS_CMAX);
    for (int item = blockIdx.x; item < DEPTH * (DFF / 64); item += gridDim.x) {
        const int layer = item / (DFF / 64), n0 = (item % (DFF / 64)) * 64; const float* W = a.in[I_WFF1] + (size_t)layer * D * DFF + n0 + cgp * 4;
        f32x4 mx = (f32x4){0.f, 0.f, 0.f, 0.f};
#pragma unroll 8
        for (int kk = 0; kk < 64; ++kk) { const f32x4 w = *(const f32x4*)(W + (size_t)(kq * 64 + kk) * DFF); mx = __builtin_elementwise_max(mx, __builtin_elementwise_abs(w)); }
#pragma unroll
        for (int j = 0; j < 4; ++j) { float v = mx[j]; v = fmaxf(v, __shfl_xor(v, 16)); v = fmaxf(v, __shfl_xor(v, 32)); mx[j] = v; }
        if (lane < 16) {
#pragma unroll
            for (int j = 0; j < 4; ++j) red[wv * 64 + cgp * 4 + j] = mx[j]; }
        LDS_BARRIER();
        if (tid < 64) { float v = 0.f;
#pragma unroll
            for (int w8 = 0; w8 < 8; ++w8) v = fmaxf(v, red[w8 * 64 + tid]);
            CM[(size_t)layer * DFF + n0 + tid] = v; }
        LDS_BARRIER();
    }
    __syncthreads();
}
__device__ void mods_phase(const Args& a, LAS float* lds) {
    const int tid = otid(), lane = tid & 63, wv = tid >> 6;
    LAS float* sl = lds;
    LAS float* red = lds + 9 * D;
    for (int i = tid; i < 9 * D; i += 512) { const int r = i >> 11, k = i & (D - 1); const float c = r < 8 ? a.in[I_C][r * D + k] : a.in[I_CCTX][k]; sl[i] = c / (1.f + __expf(-c)); }
    __syncthreads();
    float* MOD = (float*)(a.ws + WS_MOD);
    const int cgp = tid & 15, kq = tid >> 4;
    for (int item = blockIdx.x; item < DEPTH * 192; item += gridDim.x) {
        const int layer = item / 192, n0 = (item % 192) * 64;
        const float* W = a.in[I_WADA] + (size_t)layer * D * 6 * D + n0 + cgp * 4;
        f32x4 acc[9];
#pragma unroll
        for (int r = 0; r < 9; ++r) acc[r] = (f32x4){0.f, 0.f, 0.f, 0.f};
#pragma unroll 2
        for (int kk = 0; kk < 64; kk += 4) { const int k = kq * 64 + kk; f32x4 w[4];
#pragma unroll
            for (int j = 0; j < 4; ++j) w[j] = *(const f32x4*)(W + (size_t)(k + j) * 6 * D);
#pragma unroll
            for (int r = 0; r < 9; ++r) { const f32x4 s = *(const LAS f32x4*)(sl + r * D + k); acc[r] += w[0] * s[0]; acc[r] += w[1] * s[1]; acc[r] += w[2] * s[2]; acc[r] += w[3] * s[3]; } }
#pragma unroll
        for (int r = 0; r < 9; ++r)
#pragma unroll
            for (int j = 0; j < 4; ++j) { float v = acc[r][j]; v += __shfl_xor(v, 16); v += __shfl_xor(v, 32); acc[r][j] = v; }
        if (lane < 16) {
#pragma unroll
            for (int r = 0; r < 9; ++r)
#pragma unroll
                for (int j = 0; j < 4; ++j) red[(wv * 9 + r) * 64 + cgp * 4 + j] = acc[r][j]; }
        LDS_BARRIER();
        for (int o = tid; o < 9 * 64; o += 512) { const int r = o >> 6, c = o & 63; float s = a.in[I_BADA][layer * 6 * D + n0 + c];
#pragma unroll
            for (int w8 = 0; w8 < 8; ++w8) s += red[(w8 * 9 + r) * 64 + c];
            MOD[((size_t)layer * 9 + r) * 6 * D + n0 + c] = s; }
        LDS_BARRIER();
    }
}

template <int MODE> __device__ void row_phase(const Args& a, int layer, int nrows, bool write_hx, LAS float* rl) {
    const int tid = otid(), lane = tid & 63, gw = blockIdx.x * 8 + (tid >> 6), nw = gridDim.x * 8;
    const float* MOD = (const float*)(a.ws + WS_MOD); const bf16_t* Yb = (const bf16_t*)(a.ws + WS_Y); const bf16_t* YP = (const bf16_t*)(a.ws + WS_YP);
    bf16_t* XB = (bf16_t*)(a.ws + WS_XB); bf16_t* HX = (bf16_t*)(a.ws + WS_HX);
    const int nl = (MODE == 2) ? layer + 1 : layer;
    const float* gpost = (MODE == 1 ? a.in[I_GPOSTMIX] : a.in[I_GPOSTFFN]) + layer * D;
    const float* gpre = (MODE == 1 ? a.in[I_GPREFFN] + layer * D : a.in[I_GPREMIX] + nl * D);
    for (int r = gw; r < nrows; r += nw) {
        const int mr = r < MX ? (r >> 11) : 8;
        bf16_t* xb = XB + (size_t)r * D;
        f32x4 v[8];
        if (MODE == 0) { const float* src = r < MX ? a.in[I_X] + (size_t)r * D : a.in[I_CTX] + (size_t)(r - MX) * D;
#pragma unroll
            for (int i = 0; i < 8; ++i) v[i] = *(const f32x4*)(src + lane * 4 + 256 * i);
        } else {
            const float* gate = MOD + ((size_t)layer * 9 + mr) * 6 * D + (MODE == 1 ? 2 : 5) * D;
            const float* xs = r < MX ? a.in[I_X] + (size_t)r * D : a.in[I_CTX] + (size_t)(r - MX) * D;
            f32x4 y[8]; float ss = 0.f;
#pragma unroll
            for (int i = 0; i < 8; ++i) {
                if (r < MX) { const u32x2 t = *(const u32x2*)(Yb + (size_t)r * D + lane * 4 + 256 * i); y[i] = (f32x4){bflo(t.x), bfhi(t.x), bflo(t.y), bfhi(t.y)}; }
                else { const bf16_t* p = YP + (size_t)(r - MX) * D + lane * 4 + 256 * i; y[i] = (f32x4){0.f, 0.f, 0.f, 0.f};
#pragma unroll
                    for (int q = 0; q < 4; ++q) { const u32x2 t = *(const u32x2*)(p + (size_t)q * MC * D); y[i] += (f32x4){bflo(t.x), bfhi(t.x), bflo(t.y), bfhi(t.y)}; } }
                ss += y[i][0] * y[i][0] + y[i][1] * y[i][1] + y[i][2] * y[i][2] + y[i][3] * y[i][3]; }
            ss = wave_sum(ss); const float rn = rsqrtf(ss * (1.f / D) + EPS);
#pragma unroll
            for (int i = 0; i < 8; ++i) { const int c = lane * 4 + 256 * i; f32x4 xv;
                if (MODE == 1 && layer == 0) xv = *(const f32x4*)(xs + c); else { const u32x2 t = *(const u32x2*)(xb + c); xv = (f32x4){bflo(t.x), bfhi(t.x), bflo(t.y), bfhi(t.y)}; }
                const f32x4 gp = *(const f32x4*)(gpost + c), gt = *(const f32x4*)(gate + c);
                v[i] = xv + gt * (y[i] * rn * gp); }
        }
        if (MODE == 2 && !write_hx) {
#pragma unroll
            for (int i = 0; i < 8; ++i) *(f32x4*)(a.out + (size_t)r * D + lane * 4 + 256 * i) = v[i];
        } else if (MODE != 0) {
#pragma unroll
            for (int i = 0; i < 8; ++i) { u32x2 w; w.x = pg8::cvt_pk_bf16(v[i][0], v[i][1]); w.y = pg8::cvt_pk_bf16(v[i][2], v[i][3]); *(u32x2*)(xb + lane * 4 + 256 * i) = w; } }
        if (write_hx) {
            const float* mn = MOD + ((size_t)nl * 9 + mr) * 6 * D; const float* sh = mn + (MODE == 1 ? 3 : 0) * D; const float* sc = mn + (MODE == 1 ? 4 : 1) * D;
            float ss = 0.f;
#pragma unroll
            for (int i = 0; i < 8; ++i) ss += v[i][0] * v[i][0] + v[i][1] * v[i][1] + v[i][2] * v[i][2] + v[i][3] * v[i][3];
            ss = wave_sum(ss); const float rn = rsqrtf(ss * (1.f / D) + EPS);
            f32x4 hq[8];
#pragma unroll
            for (int i = 0; i < 8; ++i) { const int c = lane * 4 + 256 * i; const f32x4 g = *(const f32x4*)(gpre + c), s1 = *(const f32x4*)(sc + c), s0 = *(const f32x4*)(sh + c);
                hq[i] = v[i] * rn * g * (s1 + 1.f) + s0; }
            if (MODE != 1) {
#pragma unroll
                for (int i = 0; i < 8; ++i) { u32x2 w; w.x = pg8::cvt_pk_bf16(hq[i][0], hq[i][1]); w.y = pg8::cvt_pk_bf16(hq[i][2], hq[i][3]); *(u32x2*)(HX + (size_t)r * D + lane * 4 + 256 * i) = w; }
            } else {
                float am = 0.f;
#pragma unroll
                for (int i = 0; i < 8; ++i) am = fmaxf(am, fmaxf(fmaxf(fabsf(hq[i][0]), fabsf(hq[i][1])), fmaxf(fabsf(hq[i][2]), fabsf(hq[i][3]))));
#pragma unroll
                for (int o = 32; o; o >>= 1) am = fmaxf(am, __shfl_xor(am, o));
                const float inv = am > 0.f ? 127.f / am : 0.f;
                unsigned char* hxq = (unsigned char*)HX + (size_t)r * D;
#pragma unroll
                for (int i = 0; i < 8; ++i) { const unsigned q0 = (unsigned)(int)__builtin_rintf(hq[i][0] * inv) & 0xffu, q1 = (unsigned)(int)__builtin_rintf(hq[i][1] * inv) & 0xffu, q2 = (unsigned)(int)__builtin_rintf(hq[i][2] * inv) & 0xffu, q3 = (unsigned)(int)__builtin_rintf(hq[i][3] * inv) & 0xffu;
                    *(unsigned*)(hxq + lane * 4 + 256 * i) = q0 | (q1 << 8) | (q2 << 16) | (q3 << 24); }
                if (lane == 0) ((float*)(a.ws + WS_RSC))[r] = am * (1.f / 127.f);
            }
            if (MODE == 2 && r >= MX && nl == DEPTH - 1) {
                const float* wg = a.in[I_WIN] + (size_t)nl * D * DIN + C_G; float* gout = (float*)(a.ws + WS_GATES) + (size_t)r * 32;
                LAS float* hl = rl + (tid >> 6) * D;
#pragma unroll
                for (int i = 0; i < 8; ++i) *(LAS f32x4*)(hl + lane * 4 + 256 * i) = hq[i];
                f32x4 ga[8];
#pragma unroll
                for (int q = 0; q < 8; ++q) ga[q] = (f32x4){0.f, 0.f, 0.f, 0.f};
                for (int k = lane; k < D; k += 64) { const float hj = hl[k]; const float* wr = wg + (size_t)k * DIN;
#pragma unroll
                    for (int q = 0; q < 8; ++q) ga[q] += *(const f32x4*)(wr + 4 * q) * hj; }
#pragma unroll
                for (int q = 0; q < 8; ++q)
#pragma unroll
                    for (int j = 0; j < 4; ++j) { const float s = wave_sum(ga[q][j]); if (lane == 0) gout[q * 4 + j] = s; }
                }

        }
    }
}

__device__ void conva_phase(const Args& a, int layer, int nitems, LAS float* yl  ) {
#ifdef CA_STUB
    return;
#endif
    const int tid = otid(), lane = tid & 63, wv = tid >> 6;
    const bf16_t* PROJ = (const bf16_t*)(a.ws + WS_PROJ); bf16_t* MIX = (bf16_t*)(a.ws + WS_MIX);
    const float* cw = a.in[I_CAW] + (size_t)layer * KA * DCONV;
    LAS unsigned short* ul = (LAS unsigned short*)yl; LAS float* yt = yl + 94 * 512 / 2;
    for (int item = blockIdx.x; item < nitems; item += gridDim.x) {
        int rowbase, t0, lo, hi;
        if (item < 256) { rowbase = (item >> 5) * SEQ; t0 = (item & 31) * 64; lo = t0; hi = t0 + 64; }
        else { const int ci = item - 256; rowbase = MX + (ci >> 2) * CTXL; t0 = (ci & 3) * 64; lo = 0; hi = CTXL; }
#pragma unroll
        for (int kb = 0; kb < 2; ++kb) { u32x4 av[6], gv[6];
#pragma unroll
          for (int k = 0; k < 6; ++k) { const int i = wv + 8 * (kb * 6 + k), t = t0 - 15 + i; av[k] = (u32x4){0u, 0u, 0u, 0u}; gv[k] = av[k];
              if (i < 94 && t >= lo && t < hi) { const bf16_t* p = PROJ + (size_t)(rowbase + t) * DP + lane * 8; av[k] = *(const u32x4*)(p + P_AVAL); gv[k] = *(const u32x4*)(p + P_AGATE); } }
#pragma unroll
          for (int k = 0; k < 6; ++k) { const int i = wv + 8 * (kb * 6 + k);
              if (i < 94) { u32x4 o;
                  o.x = pg8::cvt_pk_bf16(bflo(av[k].x) * sigmoidf_(bflo(gv[k].x)), bfhi(av[k].x) * sigmoidf_(bfhi(gv[k].x)));
                  o.y = pg8::cvt_pk_bf16(bflo(av[k].y) * sigmoidf_(bflo(gv[k].y)), bfhi(av[k].y) * sigmoidf_(bfhi(gv[k].y)));
                  o.z = pg8::cvt_pk_bf16(bflo(av[k].z) * sigmoidf_(bflo(gv[k].z)), bfhi(av[k].z) * sigmoidf_(bfhi(gv[k].z)));
                  o.w = pg8::cvt_pk_bf16(bflo(av[k].w) * sigmoidf_(bflo(gv[k].w)), bfhi(av[k].w) * sigmoidf_(bfhi(gv[k].w)));
                  *(LAS u32x4*)(ul + i * 512 + lane * 8) = o; } } }
        float w[KA];
#pragma unroll
        for (int k = 0; k < KA; ++k) w[k] = cw[k * DCONV + tid];
        const float bias = a.in[I_CAB][layer * DCONV + tid];
        LDS_BARRIER();
        for (int qq = 0; qq < 4; ++qq) {
            float u[46];
#pragma unroll
            for (int i = 0; i < 46; ++i) u[i] = bf2f(ul[(qq * 16 + i) * 512 + tid]);
#pragma unroll
            for (int tt = 0; tt < 16; ++tt) { float y = bias;
#pragma unroll
                for (int k = 0; k < KA; ++k) y += w[k] * u[tt + k];
                yt[tt * 512 + tid] = y; }
            LDS_BARRIER();
#pragma unroll
            for (int q = 0; q < 2; ++q) { const int tt = wv * 2 + q; const LAS float* yr = yt + tt * 512 + lane * 8;
                const f32x4 y0 = *(const LAS f32x4*)yr, y1 = *(const LAS f32x4*)(yr + 4);
                float s = y0[0] + y0[1] + y0[2] + y0[3] + y1[0] + y1[1] + y1[2] + y1[3]; s = wave_sum(s); const float mu = s * (1.f / DCONV);
                const f32x4 d0 = y0 - mu, d1 = y1 - mu;
                float vs = d0[0] * d0[0] + d0[1] * d0[1] + d0[2] * d0[2] + d0[3] * d0[3] + d1[0] * d1[0] + d1[1] * d1[1] + d1[2] * d1[2] + d1[3] * d1[3]; vs = wave_sum(vs);
                const float rs = rsqrtf(vs * (1.f / DCONV) + EPS);
                const float* lw = a.in[I_LNAW] + layer * DCONV + lane * 8; const float* lb = a.in[I_LNAB] + layer * DCONV + lane * 8;
                float o[8];
#pragma unroll
                for (int j = 0; j < 4; ++j) { float z0 = d0[j] * rs * lw[j] + lb[j], z1 = d1[j] * rs * lw[4 + j] + lb[4 + j]; o[j] = z0 * sigmoidf_(z0); o[4 + j] = z1 * sigmoidf_(z1); }
                u32x4 pk; pk.x = pg8::cvt_pk_bf16(o[0], o[1]); pk.y = pg8::cvt_pk_bf16(o[2], o[3]); pk.z = pg8::cvt_pk_bf16(o[4], o[5]); pk.w = pg8::cvt_pk_bf16(o[6], o[7]);
                *(u32x4*)(MIX + (size_t)(rowbase + t0 + qq * 16 + tt) * D + lane * 8) = pk; }
            LDS_BARRIER();
        }
    }
}

__device__ __forceinline__ void sc_u(const bf16_t* p, float (&u)[8]) {
    const u32x4 x = *(const u32x4*)(p + P_SIN), c = *(const u32x4*)(p + P_SC);
    u[0] = bflo(x.x) * bflo(c.x); u[1] = bfhi(x.x) * bfhi(c.x); u[2] = bflo(x.y) * bflo(c.y); u[3] = bfhi(x.y) * bfhi(c.y);
    u[4] = bflo(x.z) * bflo(c.z); u[5] = bfhi(x.z) * bfhi(c.z); u[6] = bflo(x.w) * bflo(c.w); u[7] = bfhi(x.w) * bfhi(c.w); }
__device__ void shortconv_phase(const Args& a, int layer, int nrows) {
    const int tid = otid(), lane = tid & 63, gw = blockIdx.x * 8 + (tid >> 6), nw = gridDim.x * 8;
    const bf16_t* PROJ = (const bf16_t*)(a.ws + WS_PROJ); bf16_t* MIX = (bf16_t*)(a.ws + WS_MIX);
    const float* cw = a.in[I_CCW] + (size_t)layer * 3 * 512 + lane * 8;
    float w0[8], w1[8], w2[8];
#pragma unroll
    for (int j = 0; j < 8; ++j) { w0[j] = cw[j]; w1[j] = cw[512 + j]; w2[j] = cw[1024 + j]; }
    for (int r = gw; r < nrows; r += nw) {
        int dlt; bool hp, hn;
        if (r < MX) { const int g = (r & (SEQ - 1)) >> 6; dlt = 64; hp = g > 0; hn = g < 31; } else { const int t = (r - MX) & (CTXL - 1); dlt = 1; hp = t > 0; hn = t < CTXL - 1; }
        const bf16_t* p = PROJ + (size_t)r * DP + lane * 8;
        float uc[8], up[8], un[8];
        sc_u(p, uc);
        if (hp) sc_u(p - (size_t)dlt * DP, up); else {
#pragma unroll
            for (int j = 0; j < 8; ++j) up[j] = 0.f; }
        if (hn) sc_u(p + (size_t)dlt * DP, un); else {
#pragma unroll
            for (int j = 0; j < 8; ++j) un[j] = 0.f; }
        const u32x4 sb = *(const u32x4*)(p + P_SB);
        const float b[8] = {bflo(sb.x), bfhi(sb.x), bflo(sb.y), bfhi(sb.y), bflo(sb.z), bfhi(sb.z), bflo(sb.w), bfhi(sb.w)};
        float o[8];
#pragma unroll
        for (int j = 0; j < 8; ++j) o[j] = b[j] * (w0[j] * up[j] + w1[j] * uc[j] + w2[j] * un[j]);
        u32x4 pk; pk.x = pg8::cvt_pk_bf16(o[0], o[1]); pk.y = pg8::cvt_pk_bf16(o[2], o[3]); pk.z = pg8::cvt_pk_bf16(o[4], o[5]); pk.w = pg8::cvt_pk_bf16(o[6], o[7]);
        *(u32x4*)(MIX + (size_t)r * D + 1536 + lane * 8) = pk;
    }
}

__device__ void mlstm_out_phase(const Args& a, int layer, int nrows) {
    const int tid = otid(), lane = tid & 63, gw = blockIdx.x * 8 + (tid >> 6), nw = gridDim.x * 8;
    const bf16_t* PROJ = (const bf16_t*)(a.ws + WS_PROJ); bf16_t* MIX = (bf16_t*)(a.ws + WS_MIX);
    const bf16_t* HF = (const bf16_t*)(a.ws + WS_Y); const bf16_t* HB = HF + (size_t)MT * DML;
    const float* nwp = a.in[I_MNW] + layer * DML + lane * 16;
    float nwv[16];
#pragma unroll
    for (int j = 0; j < 16; ++j) nwv[j] = nwp[j];
    for (int r = gw; r < nrows; r += nw) {
        float hv[16], ov[16];
#pragma unroll
        for (int q = 0; q < 2; ++q) {
            const u32x4 f = *(const u32x4*)(HF + (size_t)r * DML + lane * 16 + q * 8), g = *(const u32x4*)(HB + (size_t)r * DML + lane * 16 + q * 8);
            const u32x4 o = *(const u32x4*)(PROJ + (size_t)r * DP + P_O + lane * 16 + q * 8);
            hv[q * 8 + 0] = bflo(f.x) + bflo(g.x); hv[q * 8 + 1] = bfhi(f.x) + bfhi(g.x); hv[q * 8 + 2] = bflo(f.y) + bflo(g.y); hv[q * 8 + 3] = bfhi(f.y) + bfhi(g.y);
            hv[q * 8 + 4] = bflo(f.z) + bflo(g.z); hv[q * 8 + 5] = bfhi(f.z) + bfhi(g.z); hv[q * 8 + 6] = bflo(f.w) + bflo(g.w); hv[q * 8 + 7] = bfhi(f.w) + bfhi(g.w);
            ov[q * 8 + 0] = bflo(o.x); ov[q * 8 + 1] = bfhi(o.x); ov[q * 8 + 2] = bflo(o.y); ov[q * 8 + 3] = bfhi(o.y); ov[q * 8 + 4] = bflo(o.z); ov[q * 8 + 5] = bfhi(o.z); ov[q * 8 + 6] = bflo(o.w); ov[q * 8 + 7] = bfhi(o.w); }
        float s = 0.f;
#pragma unroll
        for (int j = 0; j < 16; ++j) s += hv[j];
        s += __shfl_xor(s, 1); s += __shfl_xor(s, 2); s += __shfl_xor(s, 4); const float mu = s * (1.f / DH);
        float vs = 0.f;
#pragma unroll
        for (int j = 0; j < 16; ++j) { hv[j] -= mu; vs += hv[j] * hv[j]; }
        vs += __shfl_xor(vs, 1); vs += __shfl_xor(vs, 2); vs += __shfl_xor(vs, 4); const float rs = rsqrtf(vs * (1.f / DH) + EPS);
        float o[16];
#pragma unroll
        for (int j = 0; j < 16; ++j) o[j] = hv[j] * rs * nwv[j] * sigmoidf_(ov[j]);
#pragma unroll
        for (int q = 0; q < 2; ++q) { u32x4 pk; pk.x = pg8::cvt_pk_bf16(o[q * 8 + 0], o[q * 8 + 1]); pk.y = pg8::cvt_pk_bf16(o[q * 8 + 2], o[q * 8 + 3]); pk.z = pg8::cvt_pk_bf16(o[q * 8 + 4], o[q * 8 + 5]); pk.w = pg8::cvt_pk_bf16(o[q * 8 + 6], o[q * 8 + 7]);
            *(u32x4*)(MIX + (size_t)r * D + 512 + lane * 16 + q * 8) = pk; }
    }
}

constexpr int L_Q = 0, L_K = 17408, L_V = 34816, L_P = 46080, L_CT = 55296, L_S = 77056, L_H = 104704, L_W = 113920;
__device__ __forceinline__ int ml_row(int c, int j, int dir, int b) {
    int T, base, cl; if (c < 4) { T = CTXL; base = MX + b * CTXL; cl = c; } else { T = SEQ; base = b * SEQ; cl = c - 4; }
    int t = cl * 64 + j; if (dir) t = T - 1 - t; return base + t; }
__device__ __forceinline__ bf16x8 tr_frag(const LAS unsigned char* p, int rowpitch4) {
    const s16x4 lo = __builtin_amdgcn_ds_read_tr16_b64_v4i16((LAS s16x4*)p), hi = __builtin_amdgcn_ds_read_tr16_b64_v4i16((LAS s16x4*)(p + rowpitch4));
    return __builtin_shufflevector(lo, hi, 0, 1, 2, 3, 4, 5, 6, 7); }
#define MFMA16(a_, b_, c_) __builtin_amdgcn_mfma_f32_16x16x32_bf16(a_, b_, c_, 0, 0, 0)
__device__ void mlstm_phase(const Args& a, int layer, bool last, LAS unsigned char* lds) {
    const int tid = otid(), lane = tid & 63, w = __builtin_amdgcn_readfirstlane(tid >> 6), fr = lane & 15, fq = lane >> 4, q4 = fr >> 2, p4 = fr & 3;
    const float* GATES = (const float*)(a.ws + WS_GATES);
    LAS float* gA = (LAS float*)(lds + L_S); LAS float* gPM = gA + 36 * 64; LAS float* gB = gPM + 36 * 64;
    const int mj = w & 3, hf = w >> 2;
    for (int item = blockIdx.x; item < 256; item += gridDim.x) {
        const int eh = (item >> 3) & 1, chain = (item & 7) | ((item >> 4) << 3), dir = chain & 1, hd = (chain >> 1) & 7, b = chain >> 4;
        bf16_t* Hout = (bf16_t*)(a.ws + WS_Y) + (size_t)dir * MT * DML + hd * DH + eh * 64;
        const float bi = a.in[I_BGATES][layer * 32 + dir * 16 + hd], bfg = a.in[I_BGATES][layer * 32 + dir * 16 + 8 + hd];
        const bf16_t* QKVH = (const bf16_t*)(a.ws + WS_QKVH);
        const bf16_t* pq = QKVH + (size_t)(0 * NH + hd) * MT * DH; const bf16_t* pk = QKVH + (size_t)(1 * NH + hd) * MT * DH; const bf16_t* pv = QKVH + (size_t)(2 * NH + hd) * MT * DH + eh * 64;
        const float* pgi = GATES + dir * 16 + hd; const float* pgf = pgi + 8;
        for (int i = tid; i < 80 * 136 / 2; i += 512) ((LAS unsigned*)(lds + L_CT))[i] = 0u;
        { const int s = tid >> 3, c = tid & 7; ((LAS unsigned*)(lds + L_V + s * 176 + 128))[c] = 0x3F803F80u; }
        float gi5[5], gf5[5];
#pragma unroll
        for (int q = 0; q < 5; ++q) { const int c = w + 8 * q; gi5[q] = 0.f; gf5[q] = 0.f;
            if (c < 36) { const size_t Rg = (size_t)ml_row(c, lane, dir, b) * 32; gi5[q] = pgi[Rg] + bi; gf5[q] = pgf[Rg] + bfg; } }
#pragma unroll
        for (int q = 0; q < 5; ++q) { const int c = w + 8 * q;
            if (c < 36) { const float gi = gi5[q], gf = gf5[q];
            const float lf = fminf(gf, 0.f) - log1pf(expf(-fabsf(gf)));
            float bc = lf;
#pragma unroll
            for (int o = 1; o < 64; o <<= 1) { const float t = __shfl_up(bc, o); if (lane >= o) bc += t; }
            const float aa = gi - bc; float pm = aa;
#pragma unroll
            for (int o = 1; o < 64; o <<= 1) { const float t = __shfl_up(pm, o); if (lane >= o) pm = fmaxf(pm, t); }
            gA[c * 64 + lane] = aa; gPM[c * 64 + lane] = pm; gB[c * 64 + lane] = bc; } }
        f32x4 Cacc[5];
#pragma unroll
        for (int e = 0; e < 5; ++e) Cacc[e] = (f32x4){0.f, 0.f, 0.f, 0.f};
        float m_prev = 0.f;
        u32x4 qv[2], kv[2], vv;
        const int srow0 = tid >> 4, scv = tid & 15, vrow = tid >> 3, vcv = tid & 7;
#define ML_LOAD(Q_, K_, V_, cc) do { \
        _Pragma("unroll") for (int i_ = 0; i_ < 2; ++i_) { const size_t R_ = (size_t)ml_row(cc, srow0 + 32 * i_, dir, b) * DH + scv * 8; Q_[i_] = *(const u32x4*)(pq + R_); K_[i_] = *(const u32x4*)(pk + R_); } \
        V_ = *(const u32x4*)(pv + (size_t)ml_row(cc, vrow, dir, b) * DH + vcv * 8); } while (0)
        ML_LOAD(qv, kv, vv, 0);
        __syncthreads();
        for (int c = 0; c < 36; ++c) {
            const LAS float* cA = gA + c * 64; const LAS float* cPM = gPM + c * 64; const LAS float* cB = gB + c * 64;
            const float M63 = fmaxf(m_prev, cPM[63]), decay = __expf(m_prev - M63), m_next = cB[63] + M63;
            if (w == 0) { const float Ml = fmaxf(m_prev, cPM[lane]); LAS float* sw = (LAS float*)(lds + L_W);
                sw[lane] = __expf(cA[lane] - M63); sw[64 + lane] = __expf(m_prev - Ml); sw[128 + lane] = __expf(-(cB[lane] + Ml)); }
#pragma unroll
            for (int i = 0; i < 2; ++i) { *(LAS u32x4*)(lds + L_Q + (srow0 + 32 * i) * 272 + scv * 16) = qv[i]; *(LAS u32x4*)(lds + L_K + (srow0 + 32 * i) * 272 + scv * 16) = kv[i]; }
            *(LAS u32x4*)(lds + L_V + vrow * 176 + vcv * 16) = vv;
            if (c > 0 && !(last && c - 1 < 4)) { const u32x4 hv = *(const LAS u32x4*)(lds + L_H + vrow * 144 + vcv * 16); *(u32x4*)(Hout + (size_t)ml_row(c - 1, vrow, dir, b) * DML + vcv * 8) = hv; }
            if (c + 1 < 36) ML_LOAD(qv, kv, vv, c + 1);
            LDS_BARRIER();
            f32x4 nacc[3]; float Mr[4]; const int jr = mj * 16 + fr;
#ifndef REP_SEG2
#define REP_SEG2 0
#endif
            for (int r2_ = 0; r2_ <= REP_SEG2; ++r2_) {
            bf16x8 aq[4], bk[2][4], bcf[3][4];
#pragma unroll
            for (int ks = 0; ks < 4; ++ks) aq[ks] = *(const LAS bf16x8*)(lds + L_Q + (mj * 16 + fr) * 272 + ks * 64 + fq * 16);
#pragma unroll
            for (int t2 = 0; t2 < 2; ++t2)
#pragma unroll
                for (int ks = 0; ks < 4; ++ks) bk[t2][ks] = *(const LAS bf16x8*)(lds + L_K + ((2 * hf + t2) * 16 + fr) * 272 + ks * 64 + fq * 16);
#pragma unroll
            for (int i = 0; i < 3; ++i) { const int et = (i < 2) ? 2 * hf + i : 4;
#pragma unroll
                for (int ks = 0; ks < 4; ++ks) bcf[i][ks] = *(const LAS bf16x8*)(lds + L_CT + (et * 16 + fr) * 272 + ks * 64 + fq * 16); }
            Mr[0] = fmaxf(m_prev, cPM[jr]);
            const float wi = ((const LAS float*)(lds + L_W))[64 + jr];
#pragma unroll
            for (int t2 = 0; t2 < 2; ++t2) { const int ns = 2 * hf + t2; f32x4 s = (f32x4){0.f, 0.f, 0.f, 0.f};
                if (ns <= mj) {
#pragma unroll
                    for (int ks = 0; ks < 4; ++ks) s = MFMA16(bk[t2][ks], aq[ks], s); }
                const int s0 = ns * 16 + fq * 4; const f32x4 as4 = *(const LAS f32x4*)(cA + s0);
                float p[4];
#pragma unroll
                for (int jj = 0; jj < 4; ++jj) p[jj] = (s0 + jj <= jr) ? s[jj] * __expf(as4[jj] - Mr[0]) : 0.f;
                u32x2 pk; pk.x = pg8::cvt_pk_bf16(p[0], p[1]); pk.y = pg8::cvt_pk_bf16(p[2], p[3]);
                *(LAS u32x2*)(lds + L_P + jr * 144 + s0 * 2) = pk; }
#pragma unroll
            for (int i = 0; i < 3; ++i) { f32x4 n = (f32x4){0.f, 0.f, 0.f, 0.f};
#pragma unroll
                for (int ks = 0; ks < 4; ++ks) n = MFMA16(bcf[i][ks], aq[ks], n);
                nacc[i] = n * wi; }
            }
            LDS_BARRIER();
            bf16x8 ap[2], bv[5][2], akr[2];
            const float fl = ((const LAS float*)(lds + L_W))[128 + jr];
#pragma unroll
            for (int k2 = 0; k2 < 2; ++k2) ap[k2] = *(const LAS bf16x8*)(lds + L_P + (mj * 16 + fr) * 144 + k2 * 64 + fq * 16);
#pragma unroll
            for (int et = 0; et < 5; ++et)
#pragma unroll
                for (int k2 = 0; k2 < 2; ++k2) bv[et][k2] = tr_frag(lds + L_V + (k2 * 32 + fq * 8 + q4) * 176 + (et * 16 + 4 * p4) * 2, 4 * 176);
#pragma unroll
            for (int k2 = 0; k2 < 2; ++k2) akr[k2] = tr_frag(lds + L_K + (k2 * 32 + fq * 8 + q4) * 272 + (w * 16 + 4 * p4) * 2, 4 * 272);
#pragma unroll
            for (int i = 0; i < 3; ++i)
#pragma unroll
                for (int k2 = 0; k2 < 2; ++k2) { if (hf == 0) nacc[i] = MFMA16(bv[i < 2 ? i : 4][k2], ap[k2], nacc[i]); else nacc[i] = MFMA16(bv[i < 2 ? 2 + i : 4][k2], ap[k2], nacc[i]); }
            { const float dn = __builtin_amdgcn_rcpf(fmaxf(fabsf(nacc[2][0]), fl));
#pragma unroll
              for (int i = 0; i < 2; ++i) { const f32x4 hv4 = nacc[i] * dn; u32x2 pk; pk.x = pg8::cvt_pk_bf16(hv4[0], hv4[1]); pk.y = pg8::cvt_pk_bf16(hv4[2], hv4[3]);
                  *(LAS u32x2*)(lds + L_H + jr * 144 + ((2 * hf + i) * 16 + fq * 4) * 2) = pk; } }
            bf16x8 ak[2];
#pragma unroll
            for (int k2 = 0; k2 < 2; ++k2) { const bf16x8 raw = akr[k2];
                const f32x4 a0 = *(const LAS f32x4*)(lds + L_W + (k2 * 32 + fq * 8) * 4), a1 = *(const LAS f32x4*)(lds + L_W + (k2 * 32 + fq * 8 + 4) * 4);
                const float wt[8] = {a0[0], a0[1], a0[2], a0[3], a1[0], a1[1], a1[2], a1[3]};
                u32x4 pk4; pk4.x = pg8::cvt_pk_bf16(bf2f((unsigned short)raw[0]) * wt[0], bf2f((unsigned short)raw[1]) * wt[1]); pk4.y = pg8::cvt_pk_bf16(bf2f((unsigned short)raw[2]) * wt[2], bf2f((unsigned short)raw[3]) * wt[3]);
                pk4.z = pg8::cvt_pk_bf16(bf2f((unsigned short)raw[4]) * wt[4], bf2f((unsigned short)raw[5]) * wt[5]); pk4.w = pg8::cvt_pk_bf16(bf2f((unsigned short)raw[6]) * wt[6], bf2f((unsigned short)raw[7]) * wt[7]);
                ak[k2] = __builtin_bit_cast(bf16x8, pk4); }
#pragma unroll
            for (int et = 0; et < 5; ++et) { f32x4 cc = Cacc[et] * decay;
#pragma unroll
                for (int k2 = 0; k2 < 2; ++k2) cc = MFMA16(ak[k2], bv[et][k2], cc);
                Cacc[et] = cc;
                u32x2 pk2; pk2.x = pg8::cvt_pk_bf16(cc[0], cc[1]); pk2.y = pg8::cvt_pk_bf16(cc[2], cc[3]);
                *(LAS u32x2*)(lds + L_CT + (et * 16 + fr) * 272 + (w * 16 + fq * 4) * 2) = pk2; }
            m_prev = m_next;
            LDS_BARRIER();
        }
        { const u32x4 hv = *(const LAS u32x4*)(lds + L_H + vrow * 144 + vcv * 16); *(u32x4*)(Hout + (size_t)ml_row(35, vrow, dir, b) * DML + vcv * 8) = hv; }
        __syncthreads();
#undef ML_LOAD
    }
}

constexpr int NPH = 2 + 8 * DEPTH;
#ifndef REP_P0
#define REP_P0 0
#endif
#ifndef REP_ML
#define REP_ML 0
#endif
#ifndef REP_GEMM
#define REP_GEMM 0
#endif
#ifndef REP_G0
#define REP_G0 0
#endif
#ifndef REP_G1
#define REP_G1 0
#endif
#ifndef REP_G2
#define REP_G2 0
#endif
#ifndef REP_G3
#define REP_G3 0
#endif
#ifndef HOT_G0
#define HOT_G0 0
#endif
#ifndef REP_ROW0
#define REP_ROW0 0
#endif
#ifndef REP_CA
#define REP_CA 0
#endif
#ifndef REP_SC
#define REP_SC 0
#endif
#ifndef REP_MO
#define REP_MO 0
#endif
#ifndef REP_CV
#define REP_CV 0
#endif
#ifndef REP_MODS
#define REP_MODS 0
#endif
#ifndef REP_MIX
#define REP_MIX 0
#endif
__device__ void convert_layer(const Args& a, int l, LAS unsigned char* lds) {
    unsigned char* wl = a.ws + WS_W;
    for (int m = 0; m < 4; ++m) {
        const float* W; int K, N, Npad, klo = -1, khi = -1; size_t off;
        if (m == 0) { W = a.in[I_WIN] + (size_t)l * D * DIN; K = D; N = DIN; Npad = DINP; off = 0; klo = C_K; khi = C_V; }
        else if (m == 1) { W = a.in[I_WOUT] + (size_t)l * D * D; K = D; N = D; Npad = D; off = SZ_WIN; }
        else if (m == 2) { W = a.in[I_WFF1] + (size_t)l * D * DFF; K = D; N = DFF; Npad = DFF; off = SZ_WIN + SZ_WOUT; }
        else { W = a.in[I_WFF2] + (size_t)l * DFF * D; K = DFF; N = D; Npad = D; off = SZ_WIN + SZ_WOUT + SZ_WFF; }
        convert_matrix(W, K, N, Npad, (bf16_t*)(wl + off), klo, khi, (LAS float*)lds, m == 2 ? (const float*)(a.ws + WS_CMAX) + (size_t)l * DFF : nullptr, (float*)(a.ws + WS_CSC) + (size_t)l * DFF);
    }
}
__global__ void __launch_bounds__(512, 2) mega(Args a) {
    extern __shared__ __attribute__((aligned(16))) unsigned char shm[];
    LAS unsigned char* lds = (LAS unsigned char*)shm;
#ifdef ONLY_CA
    conva_phase(a, a.ph_lo, 288, (LAS float*)lds); return;
#endif
    const int lo = a.ph_lo, hi = a.ph_hi;
    if (threadIdx.x < 4) ((LAS unsigned*)(lds + LDS_BARST))[threadIdx.x] = 0u;
    __syncthreads();
    XcdBarrier xbar; xbar.bar = (unsigned*)(a.ws + WS_BAR); xbar.x = 0; xbar.st = nullptr;
    if (hi - lo > 1) xbar = xcd_barrier_post((unsigned*)(a.ws + WS_BAR), (volatile LAS unsigned*)(lds + LDS_BARST));
#define IN(k) (lo <= (k) && (k) < hi)
#ifndef REP_SYNC
#define REP_SYNC 0
#endif
#define SYNC(k) do { if (IN(k) && IN((k) + 1)) for (int rs_ = 0; rs_ <= REP_SYNC; ++rs_) { if ((k) == 0) cg::this_grid().sync(); else xcd_barrier(xbar); } } while (0)
    bf16_t* HX = (bf16_t*)(a.ws + WS_HX); bf16_t* PROJ = (bf16_t*)(a.ws + WS_PROJ); bf16_t* MIX = (bf16_t*)(a.ws + WS_MIX); bf16_t* H1 = PROJ;
    bf16_t* Yb = (bf16_t*)(a.ws + WS_Y); bf16_t* YP = (bf16_t*)(a.ws + WS_YP); float* GATES = (float*)(a.ws + WS_GATES);
    if (IN(0)) for (int rep = 0; rep <= REP_P0; ++rep) {
        colmax_phase(a, (LAS float*)lds);
        for (int r_ = 0; r_ <= REP_MODS; ++r_) mods_phase(a, (LAS float*)lds);
    }
    SYNC(0);
    if (IN(1)) { for (int rep = 0; rep <= REP_ROW0; ++rep) row_phase<0>(a, 0, MT, true, (LAS float*)lds); __syncthreads(); for (int r_ = 0; r_ <= REP_CV; ++r_) convert_layer(a, 0, lds); }
    SYNC(1);
    for (int l = 0; l < DEPTH; ++l) {
        const bool last = (l == DEPTH - 1); const int M2 = last ? MX : MT, pb = 2 + 8 * l;
        const bf16_t* wl = (const bf16_t*)(a.ws + WS_W);
        const bf16_t* WIN = wl; const bf16_t* WOUT = (const bf16_t*)((const unsigned char*)wl + SZ_WIN);
        const bf16_t* WF1 = (const bf16_t*)((const unsigned char*)wl + SZ_WIN + SZ_WOUT); const bf16_t* WF2 = (const bf16_t*)((const unsigned char*)wl + SZ_WIN + SZ_WOUT + SZ_WFF);
        if (IN(pb)) for (int rep = 0; rep <= REP_GEMM + REP_G0; ++rep) { pg8::Gemm g{HX, WIN, MT, DINP, D}; pg8::TailTilesOrder S; S.init(last ? MX : MT, DINP, D, last ? 64 : 0, 8, C_K / 256, (int)gridDim.x, (int)blockIdx.x);     pg8::EpiBf16<0> E{PROJ, DP, GATES, C_G / 256, (bf16_t*)(a.ws + WS_QKVH), MT}; pg8::gemm_phase(lds, g, S, E); }
        SYNC(pb);
        if (IN(pb + 1)) {
#ifndef SKIP_ML
 for (int rep = 0; rep <= REP_ML; ++rep) mlstm_phase(a, l, last, lds);
#endif
for (int rep = 0; rep <= REP_MIX + REP_CA; ++rep) conva_phase(a, l, last ? 256 : 288, (LAS float*)lds);
 for (int rep = 0; rep <= REP_MIX + REP_SC; ++rep) shortconv_phase(a, l, M2);
 }
        SYNC(pb + 1);
        if (IN(pb + 2)) for (int rep = 0; rep <= REP_MIX + REP_MO; ++rep) mlstm_out_phase(a, l, M2);
        SYNC(pb + 2);
        if (IN(pb + 3)) for (int rep = 0; rep <= REP_GEMM + REP_G1; ++rep) { pg8::Gemm g{MIX, WOUT, M2, D, D}; pg8::TailSplitOrder S; S.init(MX, D, D, last ? 0 : MC / 256, (int)gridDim.x, (int)blockIdx.x); pg8::EpiY E{Yb, D, YP, MX, (size_t)MC * D}; pg8::gemm_phase(lds, g, S, E); }
        SYNC(pb + 3);
        if (IN(pb + 4)) row_phase<1>(a, l, M2, true, (LAS float*)lds);
        SYNC(pb + 4);
        if (IN(pb + 5)) for (int rep = 0; rep <= REP_GEMM + REP_G2; ++rep) {
            pg8::Gemm g{HX, WF1, M2, DFF, D / 2}; pg8::StaticOrder S; S.init(M2, DFF, D / 2, (int)gridDim.x, (int)blockIdx.x);
            pg8::EpiSqReluI8 E{H1, DFF, (const float*)(a.ws + WS_RSC), (const float*)(a.ws + WS_CSC) + (size_t)l * DFF}; pg8::gemm_phase(lds, g, S, E); }
        SYNC(pb + 5);
        if (IN(pb + 6)) for (int rep = 0; rep <= REP_GEMM + REP_G3; ++rep) { pg8::Gemm g{H1, WF2, M2, D, DFF}; pg8::TailSplitOrder S; S.init(MX, D, DFF, last ? 0 : MC / 256, (int)gridDim.x, (int)blockIdx.x); pg8::EpiY E{Yb, D, YP, MX, (size_t)MC * D}; pg8::gemm_phase(lds, g, S, E); }
        SYNC(pb + 6);
        if (IN(pb + 7)) { row_phase<2>(a, l, M2, !last, (LAS float*)lds); __syncthreads(); if (!last) convert_layer(a, l + 1, lds); }
        SYNC(pb + 7);
    }
#undef IN
#undef SYNC
}

extern "C" void kernel_launch(void* const* d_in, const int* in_sizes, int n_in, void* d_out, int out_size, void* d_ws, size_t ws_size, hipStream_t stream) {
    static int grid = 0;
    if (grid == 0) {
        if (n_in != 21 || in_sizes[0] != MX * D || out_size != MX * D || ws_size < WS_END) { fprintf(stderr, "kernel_launch: unexpected shapes / workspace (n_in %d, ws %zu, need %zu)\n", n_in, ws_size, (size_t)WS_END); grid = -1; return; }
        int dev = 0, cus = 0, per_cu = 0;
        hipGetDevice(&dev); hipDeviceGetAttribute(&cus, hipDeviceAttributeMultiprocessorCount, dev);
        if (hipFuncSetAttribute((const void*)mega, hipFuncAttributeMaxDynamicSharedMemorySize, LDS_BYTES) != hipSuccess) { fprintf(stderr, "kernel_launch: hipFuncSetAttribute failed\n"); grid = -1; return; }
        if (hipOccupancyMaxActiveBlocksPerMultiprocessor(&per_cu, (const void*)mega, 512, LDS_BYTES) != hipSuccess || per_cu < 1) per_cu = 1;
        (void)hipGetLastError();
        grid = cus * 1;
    }
    if (grid < 0) return;
    Args a{};
    for (int i = 0; i < 21; ++i) a.in[i] = (const float*)d_in[i];
    a.out = (float*)d_out; a.ws = (unsigned char*)d_ws;
#if SINGLE_LAUNCH
    if (hipMemsetAsync((unsigned char*)d_ws + WS_BAR, 0, 16384, stream) != hipSuccess) { fprintf(stderr, "kernel_launch: memset failed\n"); return; }
    a.ph_lo = 0; a.ph_hi = NPH;
    void* args[] = {&a};
    hipError_t e = hipLaunchCooperativeKernel((const void*)mega, dim3(grid), dim3(512), args, LDS_BYTES, stream);
    if (e != hipSuccess) fprintf(stderr, "cooperative launch failed: %s (grid %d)\n", hipGetErrorString(e), grid);
#else
    for (int p = 0; p < NPH; ++p) { a.ph_lo = p; a.ph_hi = p + 1; hipLaunchKernelGGL(mega, dim3(grid), dim3(512), LDS_BYTES, stream, a); }
#endif
}
```

```cpp
#include <hip/hip_runtime.h>
#include <hip/hip_cooperative_groups.h>
#include <cstdio>
namespace cg = cooperative_groups;

#ifndef SINGLE_LAUNCH
#define SINGLE_LAUNCH 1
#endif
#ifndef REP_EPI
#define REP_EPI 0
#endif

namespace pg8 {
#define PG8_LAS __attribute__((address_space(3)))
typedef unsigned short bf16_t;
typedef short bf16x8 __attribute__((ext_vector_type(8)));
typedef float f32x4 __attribute__((ext_vector_type(4)));
typedef unsigned u32x4 __attribute__((ext_vector_type(4)));
constexpr int BM = 256, BK = 64, HALF = 128, HTB = HALF * BK * 2  , STAGE_BYTES = 8 * HTB, NXCD = 8, WGM = 8;

__host__ __device__ __forceinline__ int lds_byte(int r, int c) { const int st = (r >> 4) * 2 + (c >> 5), rr = r & 15, cc = c & 31, ob = rr * 64 + cc * 2; return st * 1024 + (ob ^ (((ob >> 9) & 1) << 5)); }
__host__ __device__ __forceinline__ void stage_rc(int b, int& R, int& C) { const int st = b / 1024, sb = b % 1024, swz = sb ^ (((sb >> 9) & 1) << 5); R = (st >> 1) * 16 + swz / 64; C = (st & 1) * 32 + (swz % 64) / 2; }
__host__ __device__ __forceinline__ int perm32(int rho) { const int n = rho >> 4, i = rho & 15; return 8 * (i >> 2) + 4 * n + (i & 3); }

typedef int i32x4 __attribute__((ext_vector_type(4)));
template <bool I8> struct AccT { typedef f32x4 type; };
template <> struct AccT<true> { typedef i32x4 type; };
__device__ __forceinline__ f32x4 mma16(bf16x8 a, bf16x8 b, f32x4 c) { return __builtin_amdgcn_mfma_f32_16x16x32_bf16(a, b, c, 0, 0, 0); }
__device__ __forceinline__ i32x4 mma16(bf16x8 a, bf16x8 b, i32x4 c) { return __builtin_amdgcn_mfma_i32_16x16x64_i8(__builtin_bit_cast(i32x4, a), __builtin_bit_cast(i32x4, b), c, 0, 0, 0); }
struct Unit { int pm, pn, kb, nt, part, lpm, lpn; };
struct Gemm { const bf16_t* A; const bf16_t* Bt; int M, N, K; };
struct StaticOrder {
    int nM, nN, nwg, G, c, ntf, hot = 0, wgm = WGM;
    __device__ void init(int M, int N, int K, int G_, int c_) { nM = M / BM; nN = N / BM; nwg = nM * nN; G = G_; c = c_; ntf = K / BK; }
    __device__ __forceinline__ void tile(int wgid, int& pm, int& pn) const {
        { const int q = nwg / NXCD, r = nwg % NXCD, xcd = wgid % NXCD, off = wgid / NXCD; wgid = (xcd < r ? xcd * (q + 1) : r * (q + 1) + (xcd - r) * q) + off; }
        const int nig = wgm * nN, gid = wgid / nig, fm = gid * wgm, gsz = (nM - fm) < wgm ? (nM - fm) : wgm;
        pm = fm + ((wgid % nig) % gsz); pn = (wgid % nig) / gsz; }
    __device__ bool next(int i, Unit& u) const {
        const long L = (long)i * G + c; if (L >= nwg) return false;
        int pm, pn; tile((int)L, pm, pn);
        u.pm = pm; u.pn = pn; u.kb = 0; u.nt = ntf; u.part = -1; u.lpm = hot ? 0 : pm; u.lpn = hot ? 0 : pn; return true;
    }
    __device__ __forceinline__ void a_ready(const Unit&) const {}
    __device__ __forceinline__ void done(const Unit&) const {}
};
struct TailSplitOrder {
    StaticOrder base; int nsp, K;
    __device__ void init(int M, int N, int K_, int nsp_, int G_, int c_) { base.init(M, N, K_, G_, c_); nsp = nsp_; K = K_; }
    __device__ bool next(int i, Unit& u) const {
        const long L = (long)i * base.G + base.c; const int s = (int)(L - base.nwg);
        if (L >= base.nwg && s >= nsp * base.nN * 4) return false;
        int pm, pn, kb = 0, nt = base.ntf, part = -1;
        if (L < base.nwg) base.tile((int)L, pm, pn);
        else { const int kq = s & 3, t = s >> 2; pn = t % base.nN; pm = base.nM + t / base.nN; kb = kq * (K / 4) * 2; nt = K / 4 / BK; part = kq; }
        u.pm = pm; u.pn = pn; u.kb = kb; u.nt = nt; u.part = part; u.lpm = pm; u.lpn = pn; return true;
    }
    __device__ __forceinline__ void a_ready(const Unit&) const {}
    __device__ __forceinline__ void done(const Unit&) const {}
};
struct TailTilesOrder {
    StaticOrder base; int ntail, tw, tc0;
    __device__ void init(int M, int N, int K_, int ntail_, int tw_, int tc0_, int G_, int c_) { base.init(M, N, K_, G_, c_); ntail = ntail_; tw = tw_; tc0 = tc0_; }
    __device__ bool next(int i, Unit& u) const {
        const long L = (long)i * base.G + base.c; const int s = (int)(L - base.nwg);
        if (L >= base.nwg && s >= ntail) return false;
        int pm, pn;
        if (L < base.nwg) base.tile((int)L, pm, pn); else { pm = base.nM + s / tw; pn = tc0 + s % tw; }
        u.pm = pm; u.pn = pn; u.kb = 0; u.nt = base.ntf; u.part = -1; u.lpm = pm; u.lpn = pn; return true;
    }
    __device__ __forceinline__ void a_ready(const Unit&) const {}
    __device__ __forceinline__ void done(const Unit&) const {}
};
typedef __bf16 bf16v2_t __attribute__((ext_vector_type(2)));
typedef float f32x2_t __attribute__((ext_vector_type(2)));
__device__ __forceinline__ unsigned cvt_pk_bf16(float lo, float hi) { f32x2_t v = {lo, hi}; bf16v2_t r = __builtin_convertvector(v, bf16v2_t); return __builtin_bit_cast(unsigned, r); }

struct EpiF32 {
    static constexpr bool PERM = false, AFTER_DRAIN = false, I8 = false;
    float* C; int ldc;
    __device__ __forceinline__ void operator()(const f32x4 (&acc)[2][2][4][2], const Unit& u, int wr, int wc, int fr, int fq) const {
        const int row0 = u.pm * BM + wr * 64 + fr, col0 = u.pn * BM + wc * 32 + 4 * fq;
#pragma unroll
        for (int ai = 0; ai < 2; ++ai)
#pragma unroll
            for (int m = 0; m < 4; ++m) { float* rowp = C + (size_t)(row0 + ai * HALF + m * 16) * ldc + col0;
#pragma unroll
                for (int bj = 0; bj < 2; ++bj)
#pragma unroll
                    for (int n = 0; n < 2; ++n) *(f32x4*)(rowp + bj * HALF + n * 16) = acc[ai][bj][m][n]; }
    }
};
template <int ACT> struct EpiBf16 {
    static constexpr bool PERM = true, AFTER_DRAIN = false, I8 = false;
    bf16_t* O; int ldc; float* gates; int gate_pn; bf16_t* QKV; int mt;
    __device__ __forceinline__ void operator()(const f32x4 (&acc)[2][2][4][2], const Unit& u, int wr, int wc, int fr, int fq) const {
        const int row0 = u.pm * BM + wr * 64 + fr;
        const bool gt = (ACT == 0) && (u.pn == gate_pn) && (wc == 0);
        const bool hm = (ACT == 0) && (u.pn >= 4) && (u.pn < 16);
        bf16_t* base; size_t rstride, bstride;
        if (hm) { base = QKV + ((size_t)((u.pn - 4) * 2) * mt + row0) * 128 + wc * 32 + 8 * fq; rstride = 128; bstride = (size_t)mt * 128; }
        else { const int colt = (ACT == 0) ? ((u.pn < 4 ? u.pn : u.pn - 12) * BM) : u.pn * BM; base = O + (size_t)row0 * ldc + colt + wc * 32 + 8 * fq; rstride = (size_t)ldc; bstride = HALF; }
#pragma unroll
        for (int ai = 0; ai < 2; ++ai)
#pragma unroll
            for (int m = 0; m < 4; ++m) { bf16_t* rowp = base + (size_t)(ai * HALF + m * 16) * rstride;
#pragma unroll
                for (int bj = 0; bj < 2; ++bj) { f32x4 v0 = acc[ai][bj][m][0], v1 = acc[ai][bj][m][1];
                    if (ACT == 1) {
#pragma unroll
                        for (int j = 0; j < 4; ++j) { float a0 = fmaxf(v0[j], 0.f), a1 = fmaxf(v1[j], 0.f); v0[j] = a0 * a0; v1[j] = a1 * a1; } }
                    if (ACT == 0 && bj == 0 && gt) { float* gp = gates + (size_t)(row0 + ai * HALF + m * 16) * 32 + 8 * fq; *(f32x4*)gp = v0; *(f32x4*)(gp + 4) = v1; }
                    u32x4 w; w.x = cvt_pk_bf16(v0[0], v0[1]); w.y = cvt_pk_bf16(v0[2], v0[3]); w.z = cvt_pk_bf16(v1[0], v1[1]); w.w = cvt_pk_bf16(v1[2], v1[3]);
                    *(u32x4*)(rowp + bj * bstride) = w; } }
    }
};
struct EpiY {
    static constexpr bool PERM = true, AFTER_DRAIN = false, I8 = false;
    bf16_t* O; int ldc; bf16_t* P; int row0; size_t pstride;
    __device__ __forceinline__ void operator()(const f32x4 (&acc)[2][2][4][2], const Unit& u, int wr, int wc, int fr, int fq) const {
        const int row0_ = u.pm * BM + wr * 64 + fr, col0 = u.pn * BM + wc * 32 + 8 * fq;
        if (u.part < 0) {
#pragma unroll
            for (int ai = 0; ai < 2; ++ai)
#pragma unroll
                for (int m = 0; m < 4; ++m) { bf16_t* rowp = O + (size_t)(row0_ + ai * HALF + m * 16) * ldc + col0;
#pragma unroll
                    for (int bj = 0; bj < 2; ++bj) { const f32x4 v0 = acc[ai][bj][m][0], v1 = acc[ai][bj][m][1];
                        u32x4 w; w.x = cvt_pk_bf16(v0[0], v0[1]); w.y = cvt_pk_bf16(v0[2], v0[3]); w.z = cvt_pk_bf16(v1[0], v1[1]); w.w = cvt_pk_bf16(v1[2], v1[3]);
                        *(u32x4*)(rowp + bj * HALF) = w; } }
        } else {
            bf16_t* base = P + (size_t)u.part * pstride;
#pragma unroll
            for (int ai = 0; ai < 2; ++ai)
#pragma unroll
                for (int m = 0; m < 4; ++m) { bf16_t* rowp = base + (size_t)(row0_ - row0 + ai * HALF + m * 16) * ldc + col0;
#pragma unroll
                    for (int bj = 0; bj < 2; ++bj) { const f32x4 v0 = acc[ai][bj][m][0], v1 = acc[ai][bj][m][1];
                        u32x4 w; w.x = cvt_pk_bf16(v0[0], v0[1]); w.y = cvt_pk_bf16(v0[2], v0[3]); w.z = cvt_pk_bf16(v1[0], v1[1]); w.w = cvt_pk_bf16(v1[2], v1[3]);
                        *(u32x4*)(rowp + bj * HALF) = w; } }
        }
    }
};
struct EpiProjI8 {
    static constexpr bool PERM = true, AFTER_DRAIN = false, I8 = true;
    bf16_t* O; int ldc; float* gates; int gate_pn; bf16_t* QKV; int mt; const float* rs; const float* cs;
    __device__ __forceinline__ void operator()(const i32x4 (&acc)[2][2][4][2], const Unit& u, int wr, int wc, int fr, int fq) const {
        const int row0 = u.pm * BM + wr * 64 + fr;
        const bool gt = (u.pn == gate_pn) && (wc == 0);
        const bool hm = (u.pn >= 4) && (u.pn < 16);
        bf16_t* base; size_t rstride, bstride;
        if (hm) { base = QKV + ((size_t)((u.pn - 4) * 2) * mt + row0) * 128 + wc * 32 + 8 * fq; rstride = 128; bstride = (size_t)mt * 128; }
        else { const int colt = (u.pn < 4 ? u.pn : u.pn - 12) * BM; base = O + (size_t)row0 * ldc + colt + wc * 32 + 8 * fq; rstride = (size_t)ldc; bstride = HALF; }
        f32x4 cv[2][2];
#pragma unroll
        for (int bj = 0; bj < 2; ++bj)
#pragma unroll
            for (int n = 0; n < 2; ++n) cv[bj][n] = *(const f32x4*)(cs + u.pn * BM + bj * HALF + wc * 32 + 8 * fq + 4 * n);
#pragma unroll
        for (int ai = 0; ai < 2; ++ai)
#pragma unroll
            for (int m = 0; m < 4; ++m) { const int row = row0 + ai * HALF + m * 16; bf16_t* rowp = base + (size_t)(ai * HALF + m * 16) * rstride; const float r = rs[row];
#pragma unroll
                for (int bj = 0; bj < 2; ++bj) { const i32x4 a0 = acc[ai][bj][m][0], a1 = acc[ai][bj][m][1];
                    const f32x4 v0 = (f32x4){(float)a0[0], (float)a0[1], (float)a0[2], (float)a0[3]} * cv[bj][0] * r, v1 = (f32x4){(float)a1[0], (float)a1[1], (float)a1[2], (float)a1[3]} * cv[bj][1] * r;
                    if (bj == 0 && gt) { float* gp = gates + (size_t)row * 32 + 8 * fq; *(f32x4*)gp = v0; *(f32x4*)(gp + 4) = v1; }
                    u32x4 w; w.x = cvt_pk_bf16(v0[0], v0[1]); w.y = cvt_pk_bf16(v0[2], v0[3]); w.z = cvt_pk_bf16(v1[0], v1[1]); w.w = cvt_pk_bf16(v1[2], v1[3]);
                    *(u32x4*)(rowp + bj * bstride) = w; } }
    }
};
struct EpiSqReluI8 {
    static constexpr bool PERM = true, AFTER_DRAIN = false, I8 = true;
    bf16_t* O; int ldc; const float* rs; const float* cs;
    __device__ __forceinline__ void operator()(const i32x4 (&acc)[2][2][4][2], const Unit& u, int wr, int wc, int fr, int fq) const {
        const int row0 = u.pm * BM + wr * 64 + fr, col0 = u.pn * BM + wc * 32 + 8 * fq;
        f32x4 cv[2][2];
#pragma unroll
        for (int bj = 0; bj < 2; ++bj)
#pragma unroll
            for (int n = 0; n < 2; ++n) cv[bj][n] = *(const f32x4*)(cs + col0 + bj * HALF + 4 * n);
#pragma unroll
        for (int ai = 0; ai < 2; ++ai)
#pragma unroll
            for (int m = 0; m < 4; ++m) { const int row = row0 + ai * HALF + m * 16; bf16_t* rowp = O + (size_t)row * ldc + col0; const float r = rs[row];
#pragma unroll
                for (int bj = 0; bj < 2; ++bj) { const i32x4 a0 = acc[ai][bj][m][0], a1 = acc[ai][bj][m][1];
                    f32x4 v0 = (f32x4){(float)a0[0], (float)a0[1], (float)a0[2], (float)a0[3]} * cv[bj][0] * r, v1 = (f32x4){(float)a1[0], (float)a1[1], (float)a1[2], (float)a1[3]} * cv[bj][1] * r;
#pragma unroll
                    for (int j = 0; j < 4; ++j) { const float b0 = fmaxf(v0[j], 0.f), b1 = fmaxf(v1[j], 0.f); v0[j] = b0 * b0; v1[j] = b1 * b1; }
                    u32x4 w; w.x = cvt_pk_bf16(v0[0], v0[1]); w.y = cvt_pk_bf16(v0[2], v0[3]); w.z = cvt_pk_bf16(v1[0], v1[1]); w.w = cvt_pk_bf16(v1[2], v1[3]);
                    *(u32x4*)(rowp + bj * HALF) = w; } }
    }
};

template <class Epi, class Sched, bool ALIGN_EPI = true, bool SP2 = true>
__device__ __forceinline__ void gemm_phase(PG8_LAS unsigned char* lds, const Gemm g, const Sched& S, const Epi& E) {
    int tid = threadIdx.x; asm volatile("" : "+v"(tid));
    const int wid = __builtin_amdgcn_readfirstlane(tid >> 6), lane = tid & 63, wr = wid >> 2, wc = wid & 3, fr = lane & 15, fq = lane >> 4;
    const int K = g.K;
    unsigned voffA[2], voffB[2];
#pragma unroll
    for (int i = 0; i < 2; ++i) { int R, C; stage_rc(tid * 16 + i * 8192, R, C); const int Rb = Epi::PERM ? ((R & ~31) + perm32(R & 31)) : R;
        voffA[i] = (unsigned)(R * K + C) * 2u; voffB[i] = (unsigned)(Rb * K + C) * 2u; }
    const size_t kstep = (size_t)(BK * 2);
    const size_t hstep = (size_t)HALF * K * 2;
    const size_t tstep = 2 * hstep;
    const unsigned ldsw = (unsigned)wid * 1024u;
    const int aoff = lds_byte(wr * 64 + fr, fq * 8), boff = lds_byte(wc * 32 + fr, fq * 8);
#define PG8_SA(b, h) (((b) * 2 + (h)) * HTB)
#define PG8_SB(b, h) ((4 + (b) * 2 + (h)) * HTB)
#define PG8_STAGE(bufoff, gbase, voff) do { _Pragma("unroll") for (int _i = 0; _i < 2; ++_i) \
        __builtin_amdgcn_global_load_lds((const unsigned*)((const char*)(gbase) + (voff)[_i]), (PG8_LAS unsigned*)(lds + (bufoff) + ldsw + _i * 8192), 16, 0, 0); } while (0)
#define PG8_LDA(dst, b, h) do { _Pragma("unroll") for (int m = 0; m < 4; ++m) _Pragma("unroll") for (int k = 0; k < 2; ++k) dst[m][k] = *(const PG8_LAS bf16x8*)(lds + PG8_SA(b, h) + aoff + m * 2048 + k * 1024); } while (0)
#define PG8_LDB(dst, b, h) do { _Pragma("unroll") for (int n = 0; n < 2; ++n) _Pragma("unroll") for (int k = 0; k < 2; ++k) dst[n][k] = *(const PG8_LAS bf16x8*)(lds + PG8_SB(b, h) + boff + n * 2048 + k * 1024); } while (0)
#define PG8_MMA(ai, bj, At, Bt) do { __builtin_amdgcn_s_setprio(1); _Pragma("unroll") for (int m = 0; m < 4; ++m) _Pragma("unroll") for (int n = 0; n < 2; ++n) _Pragma("unroll") for (int k = 0; k < 2; ++k) \
        acc[ai][bj][m][n] = mma16(Bt[n][k], At[m][k], acc[ai][bj][m][n]); __builtin_amdgcn_s_setprio(0); } while (0)
#define PG8_WAIT_V(n) asm volatile("s_waitcnt vmcnt(" #n ")" ::: "memory")
#define PG8_WAIT_L(n) asm volatile("s_waitcnt lgkmcnt(" #n ")" ::: "memory")
#define PG8_BAR __builtin_amdgcn_s_barrier()
#define PG8_SCHED __builtin_amdgcn_sched_barrier(0)
    Unit cur, nxt; int ui = 0;
    if (!S.next(0, cur)) return;
    typedef typename AccT<Epi::I8>::type acc_t;
    acc_t acc[2][2][4][2];
#pragma unroll
    for (int a = 0; a < 2; ++a)
#pragma unroll
        for (int b = 0; b < 2; ++b)
#pragma unroll
            for (int m = 0; m < 4; ++m)
#pragma unroll
                for (int n = 0; n < 2; ++n) acc[a][b][m][n] = (acc_t){0, 0, 0, 0};
    bf16x8 At[4][2], B0[2][2], B1[2][2];
    const char* cA = (const char*)g.A + (size_t)cur.lpm * tstep + cur.kb; const char* cB = (const char*)g.Bt + (size_t)cur.lpn * tstep + cur.kb;
    S.a_ready(cur);
    if constexpr (SP2) {
        PG8_STAGE(PG8_SB(0, 0), cB, voffB); PG8_STAGE(PG8_SB(0, 1), cB + hstep, voffB); PG8_STAGE(PG8_SA(0, 0), cA, voffA); PG8_STAGE(PG8_SA(0, 1), cA + hstep, voffA);
        if (wr == 1) PG8_BAR;
        PG8_WAIT_V(2); PG8_BAR;
        PG8_STAGE(PG8_SB(1, 0), cB + kstep, voffB); PG8_STAGE(PG8_SA(1, 0), cA + kstep, voffA); PG8_STAGE(PG8_SB(1, 1), cB + hstep + kstep, voffB);
        PG8_WAIT_V(6); PG8_BAR;
    } else {
        PG8_STAGE(PG8_SB(0, 0), cB, voffB); PG8_STAGE(PG8_SA(0, 0), cA, voffA); PG8_STAGE(PG8_SB(0, 1), cB + hstep, voffB); PG8_STAGE(PG8_SA(0, 1), cA + hstep, voffA);
        if (wr == 1) PG8_BAR;
        PG8_WAIT_V(4); PG8_BAR;
        PG8_STAGE(PG8_SB(1, 0), cB + kstep, voffB); PG8_STAGE(PG8_SA(1, 0), cA + kstep, voffA); PG8_STAGE(PG8_SB(1, 1), cB + hstep + kstep, voffB);
        PG8_WAIT_V(6); PG8_BAR;
    }
    for (;;) {
        const bool has_next = S.next(ui + 1, nxt);
        const char* nA = has_next ? (const char*)g.A + (size_t)nxt.lpm * tstep + nxt.kb : cA; const char* nB = has_next ? (const char*)g.Bt + (size_t)nxt.lpn * tstep + nxt.kb : cB;
        const int nt = cur.nt;
        for (int t = 0; t < nt; t += 2) {
            const bool last = (t == nt - 2);
            const char* a1 = cA + (size_t)(t + 1) * kstep;
            const char* a2 = last ? nA : cA + (size_t)(t + 2) * kstep; const char* b2 = last ? nB : cB + (size_t)(t + 2) * kstep;
            const char* a3 = a2 + kstep; const char* b3 = b2 + kstep;
            if (last && has_next) S.a_ready(nxt);
            if constexpr (SP2) {
            PG8_LDB(B0, 0, 0); PG8_LDB(B1, 0, 1); PG8_SCHED; PG8_LDA(At, 0, 0); PG8_STAGE(PG8_SA(1, 1), a1 + hstep, voffA);
            PG8_WAIT_V(8); PG8_WAIT_L(0); PG8_BAR; PG8_MMA(0, 0, At, B0); PG8_MMA(0, 1, At, B1); PG8_BAR; PG8_SCHED;
            PG8_LDA(At, 0, 1); PG8_STAGE(PG8_SB(0, 0), b2, voffB); PG8_STAGE(PG8_SB(0, 1), b2 + hstep, voffB); PG8_STAGE(PG8_SA(0, 0), a2, voffA);
            PG8_WAIT_V(8); PG8_WAIT_L(0); PG8_BAR; PG8_MMA(1, 0, At, B0); PG8_MMA(1, 1, At, B1); PG8_BAR; PG8_SCHED;
            PG8_LDB(B0, 1, 0); PG8_LDB(B1, 1, 1); PG8_SCHED; PG8_LDA(At, 1, 0); PG8_STAGE(PG8_SA(0, 1), a2 + hstep, voffA);
            PG8_WAIT_V(8); PG8_WAIT_L(0); PG8_BAR; PG8_MMA(0, 0, At, B0); PG8_MMA(0, 1, At, B1); PG8_BAR; PG8_SCHED;
            PG8_LDA(At, 1, 1); PG8_STAGE(PG8_SB(1, 0), b3, voffB); PG8_STAGE(PG8_SB(1, 1), b3 + hstep, voffB); PG8_STAGE(PG8_SA(1, 0), a3, voffA);
            PG8_WAIT_V(8); PG8_WAIT_L(0); PG8_BAR; PG8_MMA(1, 0, At, B0); PG8_MMA(1, 1, At, B1); PG8_BAR; PG8_SCHED;
            } else {
            PG8_LDB(B0, 0, 0); PG8_SCHED; PG8_LDA(At, 0, 0); PG8_STAGE(PG8_SA(1, 1), a1 + hstep, voffA);
            PG8_WAIT_L(8); PG8_BAR; PG8_WAIT_L(0); PG8_MMA(0, 0, At, B0); PG8_BAR; PG8_SCHED;
            PG8_LDB(B1, 0, 1); PG8_STAGE(PG8_SB(0, 0), b2, voffB);
            PG8_BAR; PG8_WAIT_L(0); PG8_MMA(0, 1, At, B1); PG8_BAR;
            PG8_LDA(At, 0, 1); PG8_STAGE(PG8_SA(0, 0), a2, voffA);
            PG8_BAR; PG8_WAIT_L(0); PG8_MMA(1, 0, At, B0); PG8_BAR; PG8_SCHED;
            PG8_STAGE(PG8_SB(0, 1), b2 + hstep, voffB);
            PG8_WAIT_V(6); PG8_BAR; PG8_MMA(1, 1, At, B1); PG8_BAR;
            PG8_LDB(B0, 1, 0); PG8_SCHED; PG8_LDA(At, 1, 0); PG8_STAGE(PG8_SA(0, 1), a2 + hstep, voffA);
            PG8_WAIT_L(8); PG8_BAR; PG8_WAIT_L(0); PG8_MMA(0, 0, At, B0); PG8_BAR; PG8_SCHED;
            PG8_LDB(B1, 1, 1); PG8_STAGE(PG8_SB(1, 0), b3, voffB);
            PG8_BAR; PG8_WAIT_L(0); PG8_MMA(0, 1, At, B1); PG8_BAR;
            PG8_LDA(At, 1, 1); PG8_STAGE(PG8_SA(1, 0), a3, voffA);
            PG8_BAR; PG8_WAIT_L(0); PG8_MMA(1, 0, At, B0); PG8_BAR; PG8_SCHED;
            PG8_STAGE(PG8_SB(1, 1), b3 + hstep, voffB);
            PG8_WAIT_V(6); PG8_BAR; PG8_MMA(1, 1, At, B1); PG8_BAR;
            }
        }
        if constexpr (ALIGN_EPI) { if (wr == 0) PG8_BAR; }
        if constexpr (!Epi::AFTER_DRAIN) { for (int re_ = 0; re_ <= REP_EPI; ++re_) E(acc, cur, wr, wc, fr, fq); S.done(cur); }
        if (!has_next) break;
#pragma unroll
        for (int a = 0; a < 2; ++a)
#pragma unroll
            for (int b = 0; b < 2; ++b)
#pragma unroll
                for (int m = 0; m < 4; ++m)
#pragma unroll
                    for (int n = 0; n < 2; ++n) acc[a][b][m][n] = (acc_t){0, 0, 0, 0};
        cur = nxt; cA = nA; cB = nB; ++ui;
        if constexpr (ALIGN_EPI) { if (wr == 1) PG8_BAR; }
    }
    PG8_WAIT_V(0);
    if constexpr (!ALIGN_EPI) { if (wr == 0) PG8_BAR; }
    PG8_BAR;
    if constexpr (Epi::AFTER_DRAIN) { E.fused(acc, cur, wr, wc, fr, fq, lds, wid, lane); S.done(cur); }
#undef PG8_SA
#undef PG8_SB
#undef PG8_STAGE
#undef PG8_LDA
#undef PG8_LDB
#undef PG8_MMA
#undef PG8_WAIT_V
#undef PG8_WAIT_L
#undef PG8_BAR
#undef PG8_SCHED
}
}
using pg8::bf16_t; using pg8::bf16x8; using pg8::f32x4; using pg8::u32x4;
#define LAS __attribute__((address_space(3)))
typedef short s16x4 __attribute__((ext_vector_type(4)));
typedef unsigned u32x2 __attribute__((ext_vector_type(2)));

constexpr int D = 2048, NB = 8, SEQ = 2048, DEPTH = 2, CTXL = 256, DCONV = 512, DML = 1024, NH = 8, DH = 128, KA = 31, DFF = 8192;
constexpr int DIN = 6688, DINP = 6912, MX = NB * SEQ, MC = NB * CTXL, MT = MX + MC;
constexpr int C_AVAL = 0, C_AGATE = 512, C_Q = 1024, C_K = 2048, C_V = 3072, C_O = 4096, C_G = 5120, C_SIN = 5152, C_SB = 5664, C_SC = 6176;
constexpr int DP = DINP - 3 * DML, P_AVAL = 0, P_AGATE = 512, P_O = C_O - 3 * DML, P_SIN = C_SIN - 3 * DML, P_SB = C_SB - 3 * DML, P_SC = C_SC - 3 * DML;
constexpr float EPS = 1e-6f;
constexpr int LDS_BYTES = 131072 + 16, LDS_BARST = 131072;
constexpr size_t SZ_WIN = (size_t)DINP * D * 2, SZ_WOUT = (size_t)D * D * 2, SZ_WFF = (size_t)DFF * D * 2, SZ_WL = SZ_WIN + SZ_WOUT + 2 * SZ_WFF;
constexpr size_t WS_W = 0, WS_XB = WS_W + SZ_WL, WS_HX = WS_XB + (size_t)MT * D * 2, WS_PROJ = WS_HX + (size_t)MT * D * 2, WS_QKVH = WS_PROJ + (size_t)MT * DP * 2, WS_MIX = WS_PROJ + (size_t)MT * DINP * 2,
                 WS_Y = WS_MIX + (size_t)MT * D * 2, WS_YP = WS_Y + (size_t)MT * D * 2, WS_GATES = WS_Y + (size_t)MT * D * 4, WS_CTX = WS_GATES + (size_t)MT * 32 * 4,
                 WS_MOD = WS_CTX + (size_t)MC * D * 4, WS_BAR = WS_MOD + (size_t)DEPTH * 9 * 6 * D * 4, WS_CMAX = WS_BAR + 16384, WS_CSC = WS_CMAX + (size_t)DEPTH * DFF * 4, WS_RSC = WS_CSC + (size_t)DEPTH * DFF * 4, WS_END = WS_RSC + (size_t)MT * 4;
static_assert((size_t)MT * DFF * 2 <= WS_Y - WS_PROJ, "H1 aliases PROJ+MIX");

struct Args { const float* in[21]; float* out; unsigned char* ws; int ph_lo, ph_hi; };
enum { I_X = 0, I_C, I_CTX, I_CCTX, I_WADA, I_BADA, I_GPREMIX, I_GPOSTMIX, I_GPREFFN, I_GPOSTFFN, I_WIN, I_BGATES, I_CAW, I_CAB, I_LNAW, I_LNAB, I_MNW, I_CCW, I_WOUT, I_WFF1, I_WFF2 };

__device__ __forceinline__ int otid() { int t = threadIdx.x; asm volatile("" : "+v"(t)); return t; }
__device__ __forceinline__ float wave_sum(float v) {
#pragma unroll
    for (int o = 32; o; o >>= 1) v += __shfl_xor(v, o);
    return v; }
__device__ __forceinline__ float bf2f(unsigned short h) { return __uint_as_float(((unsigned)h) << 16); }
__device__ __forceinline__ float bflo(unsigned w) { return __uint_as_float(w << 16); }
__device__ __forceinline__ float bfhi(unsigned w) { return __uint_as_float(w & 0xffff0000u); }
__device__ __forceinline__ unsigned short f2bf(float f) { return (unsigned short)(pg8::cvt_pk_bf16(f, 0.f) & 0xffffu); }
__device__ __forceinline__ float sigmoidf_(float x) { return __builtin_amdgcn_rcpf(1.f + __expf(-x)); }

#define XB_TMO      128
#define XB_XCNT(j)  (256  + 64 * (j))
#define XB_XSUB(j)  (1280 + 64 * (j))
#define XB_XGEN(j)  (2304 + 64 * (j))
#define XB_TOP      3328
#define XB_TOPGEN   3392
#define XCD_BAR_WORDS 3456
#define XB_SPIN_CAP (1u << 18)

__device__ __forceinline__ unsigned xb_ld(unsigned* p)              { return __hip_atomic_load(p, __ATOMIC_RELAXED, __HIP_MEMORY_SCOPE_AGENT); }
__device__ __forceinline__ unsigned xb_add(unsigned* p, unsigned v) { return __hip_atomic_fetch_add(p, v, __ATOMIC_RELAXED, __HIP_MEMORY_SCOPE_AGENT); }
__device__ __forceinline__ unsigned xb_xcc_id() { return (unsigned)__builtin_amdgcn_s_getreg((3 << 11) | 20) & 0xFu; }
#define XB_SPIN(cond, bar) do { unsigned _sp = 0; while (cond) { __builtin_amdgcn_s_sleep(1); \
    if ((++_sp & 255u) == 0u) { if (xb_ld(&(bar)[XB_TMO])) break; if (_sp > XB_SPIN_CAP) { atomicAdd(&(bar)[XB_TMO], 1u); break; } } } } while (0)

struct XcdBarrier {
    unsigned* bar; unsigned x;
    volatile LAS unsigned* st;
};

__device__ __forceinline__ XcdBarrier xcd_barrier_post(unsigned* bar, volatile LAS unsigned* st) {
    XcdBarrier b; b.bar = bar; b.x = xb_xcc_id(); b.st = st;
    if (threadIdx.x == 0) (void)xb_add(&bar[XB_XCNT(b.x)], 1u);
    return b;
}
__device__ __forceinline__ void xcd_barrier_complete(unsigned* bar, unsigned x, unsigned& nloc, unsigned& nx) {
    const unsigned G = gridDim.x * gridDim.y * gridDim.z;
    unsigned sum, cnt, mine, sp = 0u;
    for (;;) {
        sum = 0u; cnt = 0u; mine = 0u;
#pragma unroll
        for (unsigned j = 0; j < 16; ++j) { const unsigned c = xb_ld(&bar[XB_XCNT(j)]); sum += c; cnt += (c > 0u) ? 1u : 0u; mine = (j == x) ? c : mine; }
        if (sum == G) break;
        __builtin_amdgcn_s_sleep(1);
        if ((++sp & 255u) == 0u) { if (xb_ld(&bar[XB_TMO])) break; if (sp > XB_SPIN_CAP) { atomicAdd(&bar[XB_TMO], 1u); break; } }
    }
    nloc = mine > 0u ? mine : 1u; nx = cnt > 0u ? cnt : 1u;
}

__device__ __forceinline__ void xcd_barrier(const XcdBarrier& b) {
    asm volatile("s_waitcnt vmcnt(0)" ::: "memory");
    __syncthreads();
    if (threadIdx.x == 0) {
        unsigned* bar; { const unsigned long long bp_ = (unsigned long long)b.bar; unsigned lo_ = __builtin_amdgcn_readfirstlane((unsigned)bp_), hi_ = __builtin_amdgcn_readfirstlane((unsigned)(bp_ >> 32)); asm volatile("" : "+s"(lo_), "+s"(hi_)); bar = (unsigned*)(((unsigned long long)hi_ << 32) | lo_); } unsigned bx = __builtin_amdgcn_readfirstlane(b.x); asm volatile("" : "+s"(bx));
        __builtin_amdgcn_s_waitcnt(0);
        unsigned nloc = b.st[0], nx = b.st[1];
        if (nloc == 0u) { xcd_barrier_complete(bar, bx, nloc, nx); b.st[0] = nloc; b.st[1] = nx; }
        const unsigned old = xb_add(&bar[XB_XSUB(bx)], 1u);
        const unsigned gen = old / nloc;
        if (old + 1u == (gen + 1u) * nloc) {
            __builtin_amdgcn_fence(__ATOMIC_RELEASE, "agent");
            asm volatile("s_waitcnt vmcnt(0)" ::: "memory");
            const unsigned og = xb_add(&bar[XB_TOP], 1u);
            const unsigned tg = og / nx;
            if (og + 1u == (tg + 1u) * nx) xb_add(&bar[XB_TOPGEN], 1u);
            else XB_SPIN(xb_ld(&bar[XB_TOPGEN]) == tg, bar);
            __builtin_amdgcn_fence(__ATOMIC_ACQUIRE, "agent");
            xb_add(&bar[XB_XGEN(bx)], 1u);
            asm volatile("s_waitcnt vmcnt(0)" ::: "memory");
        } else {
            XB_SPIN(xb_ld(&bar[XB_XGEN(bx)]) == gen, bar);
            __builtin_amdgcn_fence(__ATOMIC_ACQUIRE, "agent");
            asm volatile("s_waitcnt vmcnt(0)" ::: "memory");
        }
    }
    __syncthreads();
}


#define LDS_BARRIER() do { asm volatile("s_waitcnt lgkmcnt(0)" ::: "memory"); __builtin_amdgcn_s_barrier(); asm volatile("" ::: "memory"); } while (0)
__device__ void convert_matrix(const float* __restrict__ W, int K, int N, int Npad, bf16_t* __restrict__ Wt, int klo, int khi, LAS float* t, const float* cmax, float* csc) {
    constexpr int CVT = 4;
    const int tid = otid(), ntk = K / 64, ntn = Npad / 64, ntiles = ntk * ntn, G = gridDim.x;
    const int kr0 = tid >> 4, c4 = tid & 15;
    f32x4 cur[CVT][2], nx[CVT][2];
#define CV_LOAD(dst, it_) do { _Pragma("unroll") for (int p_ = 0; p_ < CVT; ++p_) { const int itp_ = (it_) + p_ * G; const int tk_ = itp_ / ntn, tn_ = itp_ % ntn, n_ = tn_ * 64 + c4 * 4; \
        _Pragma("unroll") for (int i_ = 0; i_ < 2; ++i_) { dst[p_][i_] = (f32x4){0.f, 0.f, 0.f, 0.f}; \
            if (itp_ < ntiles && n_ < N) dst[p_][i_] = *(const f32x4*)(W + (size_t)(tk_ * 64 + kr0 + 32 * i_) * N + n_); } } } while (0)
    int it = blockIdx.x;
    if (it < ntiles) CV_LOAD(cur, it);
    for (; it < ntiles; it += CVT * G) {
        if (it + CVT * G < ntiles) CV_LOAD(nx, it + CVT * G);
#pragma unroll
        for (int p = 0; p < CVT; ++p)
#pragma unroll
            for (int i = 0; i < 2; ++i) { LAS float* tp = t + p * 64 * 65 + (kr0 + 32 * i) * 65 + c4 * 4; tp[0] = cur[p][i][0]; tp[1] = cur[p][i][1]; tp[2] = cur[p][i][2]; tp[3] = cur[p][i][3]; }
        LDS_BARRIER();
#pragma unroll
        for (int p = 0; p < CVT; ++p) { const int itp = it + p * G;
            if (itp < ntiles) { const int tk = itp / ntn, tn = itp % ntn, nl = tid >> 3, ks = (tid & 7) * 8, n = tn * 64 + nl; const float sc = (n >= klo && n < khi) ? 0.08838834764831845f : 1.f;
                float v[8];
                if (cmax) {
                    const float cm = cmax[n], inv = cm > 0.f ? 127.f / cm : 0.f;
#pragma unroll
                    for (int i = 0; i < 8; ++i) v[i] = t[p * 64 * 65 + (ks + i) * 65 + nl] * inv;
                    unsigned q[8];
#pragma unroll
                    for (int i = 0; i < 8; ++i) q[i] = (unsigned)(int)__builtin_rintf(v[i]) & 0xffu;
                    u32x2 w; w.x = q[0] | (q[1] << 8) | (q[2] << 16) | (q[3] << 24); w.y = q[4] | (q[5] << 8) | (q[6] << 16) | (q[7] << 24);
                    *(u32x2*)((unsigned char*)Wt + (size_t)n * K + tk * 64 + ks) = w;
                    if (tk == 0 && ks == 0) csc[n] = cm * (1.f / 127.f) * sc;
                } else {
#pragma unroll
                for (int i = 0; i < 8; ++i) v[i] = t[p * 64 * 65 + (ks + i) * 65 + nl] * sc;
                u32x4 w; w.x = pg8::cvt_pk_bf16(v[0], v[1]); w.y = pg8::cvt_pk_bf16(v[2], v[3]); w.z = pg8::cvt_pk_bf16(v[4], v[5]); w.w = pg8::cvt_pk_bf16(v[6], v[7]);
                *(u32x4*)(Wt + (size_t)n * K + tk * 64 + ks) = w; } } }
        LDS_BARRIER();
#pragma unroll
        for (int p = 0; p < CVT; ++p)
#pragma unroll
            for (int i = 0; i < 2; ++i) cur[p][i] = nx[p][i];
    }
#undef CV_LOAD
    __syncthreads();
}
__device__ void colmax_phase(const Args& a, LAS float* red) {
    const int tid = otid(), lane = tid & 63, wv = tid >> 6, cgp = tid & 15, kq = tid >> 4;
    float* CM = (float*)(a.ws + WS_CMAX);
    for (int item = blockIdx.x; item < DEPTH * (DFF / 64); item += gridDim.x) {
        const int layer = item / (DFF / 64), n0 = (item % (DFF / 64)) * 64; const float* W = a.in[I_WFF1] + (size_t)layer * D * DFF + n0 + cgp * 4;
        f32x4 mx = (f32x4){0.f, 0.f, 0.f, 0.f};
#pragma unroll 8
        for (int kk = 0; kk < 64; ++kk) { const f32x4 w = *(const f32x4*)(W + (size_t)(kq * 64 + kk) * DFF); mx = __builtin_elementwise_max(mx, __builtin_elementwise_abs(w)); }
#pragma unroll
        for (int j = 0; j < 4; ++j) { float v = mx[j]; v = fmaxf(v, __shfl_xor(v, 16)); v = fmaxf(v, __shfl_xor(v, 32)); mx[j] = v; }
        if (lane < 16) {
#pragma unroll
            for (int j = 0; j < 4; ++j) red[wv * 64 + cgp * 4 + j] = mx[j]; }
        LDS_BARRIER();
        if (tid < 64) { float v = 0.f;
#pragma unroll
            for (int w8 = 0; w8 < 8; ++w8) v = fmaxf(v, red[w8 * 64 + tid]);
            CM[(size_t)layer * DFF + n0 + tid] = v; }
        LDS_BARRIER();
    }
    __syncthreads();
}
__device__ void mods_phase(const Args& a, LAS float* lds) {
    const int tid = otid(), lane = tid & 63, wv = tid >> 6;
    LAS float* sl = lds;
    LAS float* red = lds + 9 * D;
    for (int i = tid; i < 9 * D; i += 512) { const int r = i >> 11, k = i & (D - 1); const float c = r < 8 ? a.in[I_C][r * D + k] : a.in[I_CCTX][k]; sl[i] = c / (1.f + __expf(-c)); }
    __syncthreads();
    float* MOD = (float*)(a.ws + WS_MOD);
    const int cgp = tid & 15, kq = tid >> 4;
    for (int item = blockIdx.x; item < DEPTH * 192; item += gridDim.x) {
        const int layer = item / 192, n0 = (item % 192) * 64;
        const float* W = a.in[I_WADA] + (size_t)layer * D * 6 * D + n0 + cgp * 4;
        f32x4 acc[9];
#pragma unroll
        for (int r = 0; r < 9; ++r) acc[r] = (f32x4){0.f, 0.f, 0.f, 0.f};
#pragma unroll 2
        for (int kk = 0; kk < 64; kk += 4) { const int k = kq * 64 + kk; f32x4 w[4];
#pragma unroll
            for (int j = 0; j < 4; ++j) w[j] = *(const f32x4*)(W + (size_t)(k + j) * 6 * D);
#pragma unroll
            for (int r = 0; r < 9; ++r) { const f32x4 s = *(const LAS f32x4*)(sl + r * D + k); acc[r] += w[0] * s[0]; acc[r] += w[1] * s[1]; acc[r] += w[2] * s[2]; acc[r] += w[3] * s[3]; } }
#pragma unroll
        for (int r = 0; r < 9; ++r)
#pragma unroll
            for (int j = 0; j < 4; ++j) { float v = acc[r][j]; v += __shfl_xor(v, 16); v += __shfl_xor(v, 32); acc[r][j] = v; }
        if (lane < 16) {
#pragma unroll
            for (int r = 0; r < 9; ++r)
#pragma unroll
                for (int j = 0; j < 4; ++j) red[(wv * 9 + r) * 64 + cgp * 4 + j] = acc[r][j]; }
        LDS_BARRIER();
        for (int o = tid; o < 9 * 64; o += 512) { const int r = o >> 6, c = o & 63; float s = a.in[I_BADA][layer * 6 * D + n0 + c];
#pragma unroll
            for (int w8 = 0; w8 < 8; ++w8) s += red[(w8 * 9 + r) * 64 + c];
            MOD[((size_t)layer * 9 + r) * 6 * D + n0 + c] = s; }
        LDS_BARRIER();
    }
}

template <int MODE> __device__ void row_phase(const Args& a, int layer, int nrows, bool write_hx, LAS float* rl) {
    const int tid = otid(), lane = tid & 63, gw = blockIdx.x * 8 + (tid >> 6), nw = gridDim.x * 8;
    const float* MOD = (const float*)(a.ws + WS_MOD); const bf16_t* Yb = (const bf16_t*)(a.ws + WS_Y); const bf16_t* YP = (const bf16_t*)(a.ws + WS_YP);
    bf16_t* XB = (bf16_t*)(a.ws + WS_XB); bf16_t* HX = (bf16_t*)(a.ws + WS_HX);
    const int nl = (MODE == 2) ? layer + 1 : layer;
    const float* gpost = (MODE == 1 ? a.in[I_GPOSTMIX] : a.in[I_GPOSTFFN]) + layer * D;
    const float* gpre = (MODE == 1 ? a.in[I_GPREFFN] + layer * D : a.in[I_GPREMIX] + nl * D);
    for (int r = gw; r < nrows; r += nw) {
        const int mr = r < MX ? (r >> 11) : 8;
        bf16_t* xb = XB + (size_t)r * D;
        f32x4 v[8];
        if (MODE == 0) { const float* src = r < MX ? a.in[I_X] + (size_t)r * D : a.in[I_CTX] + (size_t)(r - MX) * D;
#pragma unroll
            for (int i = 0; i < 8; ++i) v[i] = *(const f32x4*)(src + lane * 4 + 256 * i);
        } else {
            const float* gate = MOD + ((size_t)layer * 9 + mr) * 6 * D + (MODE == 1 ? 2 : 5) * D;
            const float* xs = r < MX ? a.in[I_X] + (size_t)r * D : a.in[I_CTX] + (size_t)(r - MX) * D;
            f32x4 y[8]; float ss = 0.f;
#pragma unroll
            for (int i = 0; i < 8; ++i) {
                if (r < MX) { const u32x2 t = *(const u32x2*)(Yb + (size_t)r * D + lane * 4 + 256 * i); y[i] = (f32x4){bflo(t.x), bfhi(t.x), bflo(t.y), bfhi(t.y)}; }
                else { const bf16_t* p = YP + (size_t)(r - MX) * D + lane * 4 + 256 * i; y[i] = (f32x4){0.f, 0.f, 0.f, 0.f};
#pragma unroll
                    for (int q = 0; q < 4; ++q) { const u32x2 t = *(const u32x2*)(p + (size_t)q * MC * D); y[i] += (f32x4){bflo(t.x), bfhi(t.x), bflo(t.y), bfhi(t.y)}; } }
                ss += y[i][0] * y[i][0] + y[i][1] * y[i][1] + y[i][2] * y[i][2] + y[i][3] * y[i][3]; }
            ss = wave_sum(ss); const float rn = rsqrtf(ss * (1.f / D) + EPS);
#pragma unroll
            for (int i = 0; i < 8; ++i) { const int c = lane * 4 + 256 * i; f32x4 xv;
                if (MODE == 1 && layer == 0) xv = *(const f32x4*)(xs + c); else { const u32x2 t = *(const u32x2*)(xb + c); xv = (f32x4){bflo(t.x), bfhi(t.x), bflo(t.y), bfhi(t.y)}; }
                const f32x4 gp = *(const f32x4*)(gpost + c), gt = *(const f32x4*)(gate + c);
                v[i] = xv + gt * (y[i] * rn * gp); }
        }
        if (MODE == 2 && !write_hx) {
#pragma unroll
            for (int i = 0; i < 8; ++i) *(f32x4*)(a.out + (size_t)r * D + lane * 4 + 256 * i) = v[i];
        } else if (MODE != 0) {
#pragma unroll
            for (int i = 0; i < 8; ++i) { u32x2 w; w.x = pg8::cvt_pk_bf16(v[i][0], v[i][1]); w.y = pg8::cvt_pk_bf16(v[i][2], v[i][3]); *(u32x2*)(xb + lane * 4 + 256 * i) = w; } }
        if (write_hx) {
            const float* mn = MOD + ((size_t)nl * 9 + mr) * 6 * D; const float* sh = mn + (MODE == 1 ? 3 : 0) * D; const float* sc = mn + (MODE == 1 ? 4 : 1) * D;
            float ss = 0.f;
#pragma unroll
            for (int i = 0; i < 8; ++i) ss += v[i][0] * v[i][0] + v[i][1] * v[i][1] + v[i][2] * v[i][2] + v[i][3] * v[i][3];
            ss = wave_sum(ss); const float rn = rsqrtf(ss * (1.f / D) + EPS);
            f32x4 hq[8];
#pragma unroll
            for (int i = 0; i < 8; ++i) { const int c = lane * 4 + 256 * i; const f32x4 g = *(const f32x4*)(gpre + c), s1 = *(const f32x4*)(sc + c), s0 = *(const f32x4*)(sh + c);
                hq[i] = v[i] * rn * g * (s1 + 1.f) + s0; }
            if (MODE != 1) {
#pragma unroll
                for (int i = 0; i < 8; ++i) { u32x2 w; w.x = pg8::cvt_pk_bf16(hq[i][0], hq[i][1]); w.y = pg8::cvt_pk_bf16(hq[i][2], hq[i][3]); *(u32x2*)(HX + (size_t)r * D + lane * 4 + 256 * i) = w; }
            } else {
                float am = 0.f;
#pragma unroll
                for (int i = 0; i < 8; ++i) am = fmaxf(am, fmaxf(fmaxf(fabsf(hq[i][0]), fabsf(hq[i][1])), fmaxf(fabsf(hq[i][2]), fabsf(hq[i][3]))));
#pragma unroll
                for (int o = 32; o; o >>= 1) am = fmaxf(am, __shfl_xor(am, o));
                const float inv = am > 0.f ? 127.f / am : 0.f;
                unsigned char* hxq = (unsigned char*)HX + (size_t)r * D;
#pragma unroll
                for (int i = 0; i < 8; ++i) { const unsigned q0 = (unsigned)(int)__builtin_rintf(hq[i][0] * inv) & 0xffu, q1 = (unsigned)(int)__builtin_rintf(hq[i][1] * inv) & 0xffu, q2 = (unsigned)(int)__builtin_rintf(hq[i][2] * inv) & 0xffu, q3 = (unsigned)(int)__builtin_rintf(hq[i][3] * inv) & 0xffu;
                    *(unsigned*)(hxq + lane * 4 + 256 * i) = q0 | (q1 << 8) | (q2 << 16) | (q3 << 24); }
                if (lane == 0) ((float*)(a.ws + WS_RSC))[r] = am * (1.f / 127.f);
            }
            if (MODE == 2 && r >= MX && nl == DEPTH - 1) {
                const float* wg = a.in[I_WIN] + (size_t)nl * D * DIN + C_G; float* gout = (float*)(a.ws + WS_GATES) + (size_t)r * 32;
                LAS float* hl = rl + (tid >> 6) * D;
#pragma unroll
                for (int i = 0; i < 8; ++i) *(LAS f32x4*)(hl + lane * 4 + 256 * i) = hq[i];
                f32x4 ga[8];
#pragma unroll
                for (int q = 0; q < 8; ++q) ga[q] = (f32x4){0.f, 0.f, 0.f, 0.f};
                for (int k = lane; k < D; k += 64) { const float hj = hl[k]; const float* wr = wg + (size_t)k * DIN;
#pragma unroll
                    for (int q = 0; q < 8; ++q) ga[q] += *(const f32x4*)(wr + 4 * q) * hj; }
#pragma unroll
                for (int q = 0; q < 8; ++q)
#pragma unroll
                    for (int j = 0; j < 4; ++j) { const float s = wave_sum(ga[q][j]); if (lane == 0) gout[q * 4 + j] = s; }
                }

        }
    }
}

__device__ void conva_phase(const Args& a, int layer, int nitems, LAS float* yl  ) {
#ifdef CA_STUB
    return;
#endif
    const int tid = otid(), lane = tid & 63, wv = tid >> 6;
    const bf16_t* PROJ = (const bf16_t*)(a.ws + WS_PROJ); bf16_t* MIX = (bf16_t*)(a.ws + WS_MIX);
    const float* cw = a.in[I_CAW] + (size_t)layer * KA * DCONV;
    LAS unsigned short* ul = (LAS unsigned short*)yl; LAS float* yt = yl + 94 * 512 / 2;
    for (int item = blockIdx.x; item < nitems; item += gridDim.x) {
        int rowbase, t0, lo, hi;
        if (item < 256) { rowbase = (item >> 5) * SEQ; t0 = (item & 31) * 64; lo = t0; hi = t0 + 64; }
        else { const int ci = item - 256; rowbase = MX + (ci >> 2) * CTXL; t0 = (ci & 3) * 64; lo = 0; hi = CTXL; }
#pragma unroll
        for (int kb = 0; kb < 2; ++kb) { u32x4 av[6], gv[6];
#pragma unroll
          for (int k = 0; k < 6; ++k) { const int i = wv + 8 * (kb * 6 + k), t = t0 - 15 + i; av[k] = (u32x4){0u, 0u, 0u, 0u}; gv[k] = av[k];
              if (i < 94 && t >= lo && t < hi) { const bf16_t* p = PROJ + (size_t)(rowbase + t) * DP + lane * 8; av[k] = *(const u32x4*)(p + P_AVAL); gv[k] = *(const u32x4*)(p + P_AGATE); } }
#pragma unroll
          for (int k = 0; k < 6; ++k) { const int i = wv + 8 * (kb * 6 + k);
              if (i < 94) { u32x4 o;
                  o.x = pg8::cvt_pk_bf16(bflo(av[k].x) * sigmoidf_(bflo(gv[k].x)), bfhi(av[k].x) * sigmoidf_(bfhi(gv[k].x)));
                  o.y = pg8::cvt_pk_bf16(bflo(av[k].y) * sigmoidf_(bflo(gv[k].y)), bfhi(av[k].y) * sigmoidf_(bfhi(gv[k].y)));
                  o.z = pg8::cvt_pk_bf16(bflo(av[k].z) * sigmoidf_(bflo(gv[k].z)), bfhi(av[k].z) * sigmoidf_(bfhi(gv[k].z)));
                  o.w = pg8::cvt_pk_bf16(bflo(av[k].w) * sigmoidf_(bflo(gv[k].w)), bfhi(av[k].w) * sigmoidf_(bfhi(gv[k].w)));
                  *(LAS u32x4*)(ul + i * 512 + lane * 8) = o; } } }
        float w[KA];
#pragma unroll
        for (int k = 0; k < KA; ++k) w[k] = cw[k * DCONV + tid];
        const float bias = a.in[I_CAB][layer * DCONV + tid];
        LDS_BARRIER();
        for (int qq = 0; qq < 4; ++qq) {
            float u[46];
#pragma unroll
            for (int i = 0; i < 46; ++i) u[i] = bf2f(ul[(qq * 16 + i) * 512 + tid]);
#pragma unroll
            for (int tt = 0; tt < 16; ++tt) { float y = bias;
#pragma unroll
                for (int k = 0; k < KA; ++k) y += w[k] * u[tt + k];
                yt[tt * 512 + tid] = y; }
            LDS_BARRIER();
#pragma unroll
            for (int q = 0; q < 2; ++q) { const int tt = wv * 2 + q; const LAS float* yr = yt + tt * 512 + lane * 8;
                const f32x4 y0 = *(const LAS f32x4*)yr, y1 = *(const LAS f32x4*)(yr + 4);
                float s = y0[0] + y0[1] + y0[2] + y0[3] + y1[0] + y1[1] + y1[2] + y1[3]; s = wave_sum(s); const float mu = s * (1.f / DCONV);
                const f32x4 d0 = y0 - mu, d1 = y1 - mu;
                float vs = d0[0] * d0[0] + d0[1] * d0[1] + d0[2] * d0[2] + d0[3] * d0[3] + d1[0] * d1[0] + d1[1] * d1[1] + d1[2] * d1[2] + d1[3] * d1[3]; vs = wave_sum(vs);
                const float rs = rsqrtf(vs * (1.f / DCONV) + EPS);
                const float* lw = a.in[I_LNAW] + layer * DCONV + lane * 8; const float* lb = a.in[I_LNAB] + layer * DCONV + lane * 8;
                float o[8];
#pragma unroll
                for (int j = 0; j < 4; ++j) { float z0 = d0[j] * rs * lw[j] + lb[j], z1 = d1[j] * rs * lw[4 + j] + lb[4 + j]; o[j] = z0 * sigmoidf_(z0); o[4 + j] = z1 * sigmoidf_(z1); }
                u32x4 pk; pk.x = pg8::cvt_pk_bf16(o[0], o[1]); pk.y = pg8::cvt_pk_bf16(o[2], o[3]); pk.z = pg8::cvt_pk_bf16(o[4], o[5]); pk.w = pg8::cvt_pk_bf16(o[6], o[7]);
                *(u32x4*)(MIX + (size_t)(rowbase + t0 + qq * 16 + tt) * D + lane * 8) = pk; }
            LDS_BARRIER();
        }
    }
}

__device__ __forceinline__ void sc_u(const bf16_t* p, float (&u)[8]) {
    const u32x4 x = *(const u32x4*)(p + P_SIN), c = *(const u32x4*)(p + P_SC);
    u[0] = bflo(x.x) * bflo(c.x); u[1] = bfhi(x.x) * bfhi(c.x); u[2] = bflo(x.y) * bflo(c.y); u[3] = bfhi(x.y) * bfhi(c.y);
    u[4] = bflo(x.z) * bflo(c.z); u[5] = bfhi(x.z) * bfhi(c.z); u[6] = bflo(x.w) * bflo(c.w); u[7] = bfhi(x.w) * bfhi(c.w); }
__device__ void shortconv_phase(const Args& a, int layer, int nrows) {
    const int tid = otid(), lane = tid & 63, gw = blockIdx.x * 8 + (tid >> 6), nw = gridDim.x * 8;
    const bf16_t* PROJ = (const bf16_t*)(a.ws + WS_PROJ); bf16_t* MIX = (bf16_t*)(a.ws + WS_MIX);
    const float* cw = a.in[I_CCW] + (size_t)layer * 3 * 512 + lane * 8;
    float w0[8], w1[8], w2[8];
#pragma unroll
    for (int j = 0; j < 8; ++j) { w0[j] = cw[j]; w1[j] = cw[512 + j]; w2[j] = cw[1024 + j]; }
    for (int r = gw; r < nrows; r += nw) {
        int dlt; bool hp, hn;
        if (r < MX) { const int g = (r & (SEQ - 1)) >> 6; dlt = 64; hp = g > 0; hn = g < 31; } else { const int t = (r - MX) & (CTXL - 1); dlt = 1; hp = t > 0; hn = t < CTXL - 1; }
        const bf16_t* p = PROJ + (size_t)r * DP + lane * 8;
        float uc[8], up[8], un[8];
        sc_u(p, uc);
        if (hp) sc_u(p - (size_t)dlt * DP, up); else {
#pragma unroll
            for (int j = 0; j < 8; ++j) up[j] = 0.f; }
        if (hn) sc_u(p + (size_t)dlt * DP, un); else {
#pragma unroll
            for (int j = 0; j < 8; ++j) un[j] = 0.f; }
        const u32x4 sb = *(const u32x4*)(p + P_SB);
        const float b[8] = {bflo(sb.x), bfhi(sb.x), bflo(sb.y), bfhi(sb.y), bflo(sb.z), bfhi(sb.z), bflo(sb.w), bfhi(sb.w)};
        float o[8];
#pragma unroll
        for (int j = 0; j < 8; ++j) o[j] = b[j] * (w0[j] * up[j] + w1[j] * uc[j] + w2[j] * un[j]);
        u32x4 pk; pk.x = pg8::cvt_pk_bf16(o[0], o[1]); pk.y = pg8::cvt_pk_bf16(o[2], o[3]); pk.z = pg8::cvt_pk_bf16(o[4], o[5]); pk.w = pg8::cvt_pk_bf16(o[6], o[7]);
        *(u32x4*)(MIX + (size_t)r * D + 1536 + lane * 8) = pk;
    }
}

__device__ void mlstm_out_phase(const Args& a, int layer, int nrows) {
    const int tid = otid(), lane = tid & 63, gw = blockIdx.x * 8 + (tid >> 6), nw = gridDim.x * 8;
    const bf16_t* PROJ = (const bf16_t*)(a.ws + WS_PROJ); bf16_t* MIX = (bf16_t*)(a.ws + WS_MIX);
    const bf16_t* HF = (const bf16_t*)(a.ws + WS_Y); const bf16_t* HB = HF + (size_t)MT * DML;
    const float* nwp = a.in[I_MNW] + layer * DML + lane * 16;
    float nwv[16];
#pragma unroll
    for (int j = 0; j < 16; ++j) nwv[j] = nwp[j];
    for (int r = gw; r < nrows; r += nw) {
        float hv[16], ov[16];
#pragma unroll
        for (int q = 0; q < 2; ++q) {
            const u32x4 f = *(const u32x4*)(HF + (size_t)r * DML + lane * 16 + q * 8), g = *(const u32x4*)(HB + (size_t)r * DML + lane * 16 + q * 8);
            const u32x4 o = *(const u32x4*)(PROJ + (size_t)r * DP + P_O + lane * 16 + q * 8);
            hv[q * 8 + 0] = bflo(f.x) + bflo(g.x); hv[q * 8 + 1] = bfhi(f.x) + bfhi(g.x); hv[q * 8 + 2] = bflo(f.y) + bflo(g.y); hv[q * 8 + 3] = bfhi(f.y) + bfhi(g.y);
            hv[q * 8 + 4] = bflo(f.z) + bflo(g.z); hv[q * 8 + 5] = bfhi(f.z) + bfhi(g.z); hv[q * 8 + 6] = bflo(f.w) + bflo(g.w); hv[q * 8 + 7] = bfhi(f.w) + bfhi(g.w);
            ov[q * 8 + 0] = bflo(o.x); ov[q * 8 + 1] = bfhi(o.x); ov[q * 8 + 2] = bflo(o.y); ov[q * 8 + 3] = bfhi(o.y); ov[q * 8 + 4] = bflo(o.z); ov[q * 8 + 5] = bfhi(o.z); ov[q * 8 + 6] = bflo(o.w); ov[q * 8 + 7] = bfhi(o.w); }
        float s = 0.f;
#pragma unroll
        for (int j = 0; j < 16; ++j) s += hv[j];
        s += __shfl_xor(s, 1); s += __shfl_xor(s, 2); s += __shfl_xor(s, 4); const float mu = s * (1.f / DH);
        float vs = 0.f;
#pragma unroll
        for (int j = 0; j < 16; ++j) { hv[j] -= mu; vs += hv[j] * hv[j]; }
        vs += __shfl_xor(vs, 1); vs += __shfl_xor(vs, 2); vs += __shfl_xor(vs, 4); const float rs = rsqrtf(vs * (1.f / DH) + EPS);
        float o[16];
#pragma unroll
        for (int j = 0; j < 16; ++j) o[j] = hv[j] * rs * nwv[j] * sigmoidf_(ov[j]);
#pragma unroll
        for (int q = 0; q < 2; ++q) { u32x4 pk; pk.x = pg8::cvt_pk_bf16(o[q * 8 + 0], o[q * 8 + 1]); pk.y = pg8::cvt_pk_bf16(o[q * 8 + 2], o[q * 8 + 3]); pk.z = pg8::cvt_pk_bf16(o[q * 8 + 4], o[q * 8 + 5]); pk.w = pg8::cvt_pk_bf16(o[q * 8 + 6], o[q * 8 + 7]);
            *(u32x4*)(MIX + (size_t)r * D + 512 + lane * 16 + q * 8) = pk; }
    }
}

constexpr int L_Q = 0, L_K = 17408, L_V = 34816, L_P = 46080, L_CT = 55296, L_S = 77056, L_H = 104704, L_W = 113920;
__device__ __forceinline__ int ml_row(int c, int j, int dir, int b) {
    int T, base, cl; if (c < 4) { T = CTXL; base = MX + b * CTXL; cl = c; } else { T = SEQ; base = b * SEQ; cl = c - 4; }
    int t = cl * 64 + j; if (dir) t = T - 1 - t; return base + t; }
__device__ __forceinline__ bf16x8 tr_frag(const LAS unsigned char* p, int rowpitch4) {
    const s16x4 lo = __builtin_amdgcn_ds_read_tr16_b64_v4i16((LAS s16x4*)p), hi = __builtin_amdgcn_ds_read_tr16_b64_v4i16((LAS s16x4*)(p + rowpitch4));
    return __builtin_shufflevector(lo, hi, 0, 1, 2, 3, 4, 5, 6, 7); }
#define MFMA16(a_, b_, c_) __builtin_amdgcn_mfma_f32_16x16x32_bf16(a_, b_, c_, 0, 0, 0)
__device__ void mlstm_phase(const Args& a, int layer, bool last, LAS unsigned char* lds) {
    const int tid = otid(), lane = tid & 63, w = __builtin_amdgcn_readfirstlane(tid >> 6), fr = lane & 15, fq = lane >> 4, q4 = fr >> 2, p4 = fr & 3;
    const float* GATES = (const float*)(a.ws + WS_GATES);
    LAS float* gA = (LAS float*)(lds + L_S); LAS float* gPM = gA + 36 * 64; LAS float* gB = gPM + 36 * 64;
    const int mj = w & 3, hf = w >> 2;
    for (int item = blockIdx.x; item < 256; item += gridDim.x) {
        const int eh = (item >> 3) & 1, chain = (item & 7) | ((item >> 4) << 3), dir = chain & 1, hd = (chain >> 1) & 7, b = chain >> 4;
        bf16_t* Hout = (bf16_t*)(a.ws + WS_Y) + (size_t)dir * MT * DML + hd * DH + eh * 64;
        const float bi = a.in[I_BGATES][layer * 32 + dir * 16 + hd], bfg = a.in[I_BGATES][layer * 32 + dir * 16 + 8 + hd];
        const bf16_t* QKVH = (const bf16_t*)(a.ws + WS_QKVH);
        const bf16_t* pq = QKVH + (size_t)(0 * NH + hd) * MT * DH; const bf16_t* pk = QKVH + (size_t)(1 * NH + hd) * MT * DH; const bf16_t* pv = QKVH + (size_t)(2 * NH + hd) * MT * DH + eh * 64;
        const float* pgi = GATES + dir * 16 + hd; const float* pgf = pgi + 8;
        for (int i = tid; i < 80 * 136 / 2; i += 512) ((LAS unsigned*)(lds + L_CT))[i] = 0u;
        { const int s = tid >> 3, c = tid & 7; ((LAS unsigned*)(lds + L_V + s * 176 + 128))[c] = 0x3F803F80u; }
        float gi5[5], gf5[5];
#pragma unroll
        for (int q = 0; q < 5; ++q) { const int c = w + 8 * q; gi5[q] = 0.f; gf5[q] = 0.f;
            if (c < 36) { const size_t Rg = (size_t)ml_row(c, lane, dir, b) * 32; gi5[q] = pgi[Rg] + bi; gf5[q] = pgf[Rg] + bfg; } }
#pragma unroll
        for (int q = 0; q < 5; ++q) { const int c = w + 8 * q;
            if (c < 36) { const float gi = gi5[q], gf = gf5[q];
            const float lf = fminf(gf, 0.f) - log1pf(expf(-fabsf(gf)));
            float bc = lf;
#pragma unroll
            for (int o = 1; o < 64; o <<= 1) { const float t = __shfl_up(bc, o); if (lane >= o) bc += t; }
            const float aa = gi - bc; float pm = aa;
#pragma unroll
            for (int o = 1; o < 64; o <<= 1) { const float t = __shfl_up(pm, o); if (lane >= o) pm = fmaxf(pm, t); }
            gA[c * 64 + lane] = aa; gPM[c * 64 + lane] = pm; gB[c * 64 + lane] = bc; } }
        f32x4 Cacc[5];
#pragma unroll
        for (int e = 0; e < 5; ++e) Cacc[e] = (f32x4){0.f, 0.f, 0.f, 0.f};
        float m_prev = 0.f;
        u32x4 qv[2], kv[2], vv;
        const int srow0 = tid >> 4, scv = tid & 15, vrow = tid >> 3, vcv = tid & 7;
#define ML_LOAD(Q_, K_, V_, cc) do { \
        _Pragma("unroll") for (int i_ = 0; i_ < 2; ++i_) { const size_t R_ = (size_t)ml_row(cc, srow0 + 32 * i_, dir, b) * DH + scv * 8; Q_[i_] = *(const u32x4*)(pq + R_); K_[i_] = *(const u32x4*)(pk + R_); } \
        V_ = *(const u32x4*)(pv + (size_t)ml_row(cc, vrow, dir, b) * DH + vcv * 8); } while (0)
        ML_LOAD(qv, kv, vv, 0);
        __syncthreads();
        for (int c = 0; c < 36; ++c) {
            const LAS float* cA = gA + c * 64; const LAS float* cPM = gPM + c * 64; const LAS float* cB = gB + c * 64;
            const float M63 = fmaxf(m_prev, cPM[63]), decay = __expf(m_prev - M63), m_next = cB[63] + M63;
            if (w == 0) { const float Ml = fmaxf(m_prev, cPM[lane]); LAS float* sw = (LAS float*)(lds + L_W);
                sw[lane] = __expf(cA[lane] - M63); sw[64 + lane] = __expf(m_prev - Ml); sw[128 + lane] = __expf(-(cB[lane] + Ml)); }
#pragma unroll
            for (int i = 0; i < 2; ++i) { *(LAS u32x4*)(lds + L_Q + (srow0 + 32 * i) * 272 + scv * 16) = qv[i]; *(LAS u32x4*)(lds + L_K + (srow0 + 32 * i) * 272 + scv * 16) = kv[i]; }
            *(LAS u32x4*)(lds + L_V + vrow * 176 + vcv * 16) = vv;
            if (c > 0 && !(last && c - 1 < 4)) { const u32x4 hv = *(const LAS u32x4*)(lds + L_H + vrow * 144 + vcv * 16); *(u32x4*)(Hout + (size_t)ml_row(c - 1, vrow, dir, b) * DML + vcv * 8) = hv; }
            if (c + 1 < 36) ML_LOAD(qv, kv, vv, c + 1);
            LDS_BARRIER();
            f32x4 nacc[3]; float Mr[4]; const int jr = mj * 16 + fr;
#ifndef REP_SEG2
#define REP_SEG2 0
#endif
            for (int r2_ = 0; r2_ <= REP_SEG2; ++r2_) {
            bf16x8 aq[4], bk[2][4], bcf[3][4];
#pragma unroll
            for (int ks = 0; ks < 4; ++ks) aq[ks] = *(const LAS bf16x8*)(lds + L_Q + (mj * 16 + fr) * 272 + ks * 64 + fq * 16);
#pragma unroll
            for (int t2 = 0; t2 < 2; ++t2)
#pragma unroll
                for (int ks = 0; ks < 4; ++ks) bk[t2][ks] = *(const LAS bf16x8*)(lds + L_K + ((2 * hf + t2) * 16 + fr) * 272 + ks * 64 + fq * 16);
#pragma unroll
            for (int i = 0; i < 3; ++i) { const int et = (i < 2) ? 2 * hf + i : 4;
#pragma unroll
                for (int ks = 0; ks < 4; ++ks) bcf[i][ks] = *(const LAS bf16x8*)(lds + L_CT + (et * 16 + fr) * 272 + ks * 64 + fq * 16); }
            Mr[0] = fmaxf(m_prev, cPM[jr]);
            const float wi = ((const LAS float*)(lds + L_W))[64 + jr];
#pragma unroll
            for (int t2 = 0; t2 < 2; ++t2) { const int ns = 2 * hf + t2; f32x4 s = (f32x4){0.f, 0.f, 0.f, 0.f};
                if (ns <= mj) {
#pragma unroll
                    for (int ks = 0; ks < 4; ++ks) s = MFMA16(bk[t2][ks], aq[ks], s); }
                const int s0 = ns * 16 + fq * 4; const f32x4 as4 = *(const LAS f32x4*)(cA + s0);
                float p[4];
#pragma unroll
                for (int jj = 0; jj < 4; ++jj) p[jj] = (s0 + jj <= jr) ? s[jj] * __expf(as4[jj] - Mr[0]) : 0.f;
                u32x2 pk; pk.x = pg8::cvt_pk_bf16(p[0], p[1]); pk.y = pg8::cvt_pk_bf16(p[2], p[3]);
                *(LAS u32x2*)(lds + L_P + jr * 144 + s0 * 2) = pk; }
#pragma unroll
            for (int i = 0; i < 3; ++i) { f32x4 n = (f32x4){0.f, 0.f, 0.f, 0.f};
#pragma unroll
                for (int ks = 0; ks < 4; ++ks) n = MFMA16(bcf[i][ks], aq[ks], n);
                nacc[i] = n * wi; }
            }
            LDS_BARRIER();
            bf16x8 ap[2], bv[5][2], akr[2];
            const float fl = ((const LAS float*)(lds + L_W))[128 + jr];
#pragma unroll
            for (int k2 = 0; k2 < 2; ++k2) ap[k2] = *(const LAS bf16x8*)(lds + L_P + (mj * 16 + fr) * 144 + k2 * 64 + fq * 16);
#pragma unroll
            for (int et = 0; et < 5; ++et)
#pragma unroll
                for (int k2 = 0; k2 < 2; ++k2) bv[et][k2] = tr_frag(lds + L_V + (k2 * 32 + fq * 8 + q4) * 176 + (et * 16 + 4 * p4) * 2, 4 * 176);
#pragma unroll
            for (int k2 = 0; k2 < 2; ++k2) akr[k2] = tr_frag(lds + L_K + (k2 * 32 + fq * 8 + q4) * 272 + (w * 16 + 4 * p4) * 2, 4 * 272);
#pragma unroll
            for (int i = 0; i < 3; ++i)
#pragma unroll
                for (int k2 = 0; k2 < 2; ++k2) { if (hf == 0) nacc[i] = MFMA16(bv[i < 2 ? i : 4][k2], ap[k2], nacc[i]); else nacc[i] = MFMA16(bv[i < 2 ? 2 + i : 4][k2], ap[k2], nacc[i]); }
            { const float dn = __builtin_amdgcn_rcpf(fmaxf(fabsf(nacc[2][0]), fl));
#pragma unroll
              for (int i = 0; i < 2; ++i) { const f32x4 hv4 = nacc[i] * dn; u32x2 pk; pk.x = pg8::cvt_pk_bf16(hv4[0], hv4[1]); pk.y = pg8::cvt_pk_bf16(hv4[2], hv4[3]);
                  *(LAS u32x2*)(lds + L_H + jr * 144 + ((2 * hf + i) * 16 + fq * 4) * 2) = pk; } }
            bf16x8 ak[2];
#pragma unroll
            for (int k2 = 0; k2 < 2; ++k2) { const bf16x8 raw = akr[k2];
                const f32x4 a0 = *(const LAS f32x4*)(lds + L_W + (k2 * 32 + fq * 8) * 4), a1 = *(const LAS f32x4*)(lds + L_W + (k2 * 32 + fq * 8 + 4) * 4);
                const float wt[8] = {a0[0], a0[1], a0[2], a0[3], a1[0], a1[1], a1[2], a1[3]};
                u32x4 pk4; pk4.x = pg8::cvt_pk_bf16(bf2f((unsigned short)raw[0]) * wt[0], bf2f((unsigned short)raw[1]) * wt[1]); pk4.y = pg8::cvt_pk_bf16(bf2f((unsigned short)raw[2]) * wt[2], bf2f((unsigned short)raw[3]) * wt[3]);
                pk4.z = pg8::cvt_pk_bf16(bf2f((unsigned short)raw[4]) * wt[4], bf2f((unsigned short)raw[5]) * wt[5]); pk4.w = pg8::cvt_pk_bf16(bf2f((unsigned short)raw[6]) * wt[6], bf2f((unsigned short)raw[7]) * wt[7]);
                ak[k2] = __builtin_bit_cast(bf16x8, pk4); }
#pragma unroll
            for (int et = 0; et < 5; ++et) { f32x4 cc = Cacc[et] * decay;
#pragma unroll
                for (int k2 = 0; k2 < 2; ++k2) cc = MFMA16(ak[k2], bv[et][k2], cc);
                Cacc[et] = cc;
                u32x2 pk2; pk2.x = pg8::cvt_pk_bf16(cc[0], cc[1]); pk2.y = pg8::cvt_pk_bf16(cc[2], cc[3]);
                *(LAS u32x2*)(lds + L_CT + (et * 16 + fr) * 272 + (w * 16 + fq * 4) * 2) = pk2; }
            m_prev = m_next;
            LDS_BARRIER();
        }
        { const u32x4 hv = *(const LAS u32x4*)(lds + L_H + vrow * 144 + vcv * 16); *(u32x4*)(Hout + (size_t)ml_row(35, vrow, dir, b) * DML + vcv * 8) = hv; }
        __syncthreads();
#undef ML_LOAD
    }
}

constexpr int NPH = 2 + 8 * DEPTH;
#ifndef REP_P0
#define REP_P0 0
#endif
#ifndef REP_ML
#define REP_ML 0
#endif
#ifndef REP_GEMM
#define REP_GEMM 0
#endif
#ifndef REP_G0
#define REP_G0 0
#endif
#ifndef REP_G1
#define REP_G1 0
#endif
#ifndef REP_G2
#define REP_G2 0
#endif
#ifndef REP_G3
#define REP_G3 0
#endif
#ifndef HOT_G0
#define HOT_G0 0
#endif
#ifndef REP_ROW0
#define REP_ROW0 0
#endif
#ifndef REP_CA
#define REP_CA 0
#endif
#ifndef REP_SC
#define REP_SC 0
#endif
#ifndef REP_MO
#define REP_MO 0
#endif
#ifndef REP_CV
#define REP_CV 0
#endif
#ifndef REP_MODS
#define REP_MODS 0
#endif
#ifndef REP_MIX
#define REP_MIX 0
#endif
__device__ void convert_layer(const Args& a, int l, LAS unsigned char* lds) {
    unsigned char* wl = a.ws + WS_W;
    for (int m = 0; m < 4; ++m) {
        const float* W; int K, N, Npad, klo = -1, khi = -1; size_t off;
        if (m == 0) { W = a.in[I_WIN] + (size_t)l * D * DIN; K = D; N = DIN; Npad = DINP; off = 0; klo = C_K; khi = C_V; }
        else if (m == 1) { W = a.in[I_WOUT] + (size_t)l * D * D; K = D; N = D; Npad = D; off = SZ_WIN; }
        else if (m == 2) { W = a.in[I_WFF1] + (size_t)l * D * DFF; K = D; N = DFF; Npad = DFF; off = SZ_WIN + SZ_WOUT; }
        else { W = a.in[I_WFF2] + (size_t)l * DFF * D; K = DFF; N = D; Npad = D; off = SZ_WIN + SZ_WOUT + SZ_WFF; }
        convert_matrix(W, K, N, Npad, (bf16_t*)(wl + off), klo, khi, (LAS float*)lds, m == 2 ? (const float*)(a.ws + WS_CMAX) + (size_t)l * DFF : nullptr, (float*)(a.ws + WS_CSC) + (size_t)l * DFF);
    }
}
__global__ void __launch_bounds__(512, 2) mega(Args a) {
    extern __shared__ __attribute__((aligned(16))) unsigned char shm[];
    LAS unsigned char* lds = (LAS unsigned char*)shm;
#ifdef ONLY_CA
    conva_phase(a, a.ph_lo, 288, (LAS float*)lds); return;
#endif
    const int lo = a.ph_lo, hi = a.ph_hi;
    if (threadIdx.x < 4) ((LAS unsigned*)(lds + LDS_BARST))[threadIdx.x] = 0u;
    __syncthreads();
    XcdBarrier xbar; xbar.bar = (unsigned*)(a.ws + WS_BAR); xbar.x = 0; xbar.st = nullptr;
    if (hi - lo > 1) xbar = xcd_barrier_post((unsigned*)(a.ws + WS_BAR), (volatile LAS unsigned*)(lds + LDS_BARST));
#define IN(k) (lo <= (k) && (k) < hi)
#ifndef REP_SYNC
#define REP_SYNC 0
#endif
#define SYNC(k) do { if (IN(k) && IN((k) + 1)) for (int rs_ = 0; rs_ <= REP_SYNC; ++rs_) { if ((k) == 0) cg::this_grid().sync(); else xcd_barrier(xbar); } } while (0)
    bf16_t* HX = (bf16_t*)(a.ws + WS_HX); bf16_t* PROJ = (bf16_t*)(a.ws + WS_PROJ); bf16_t* MIX = (bf16_t*)(a.ws + WS_MIX); bf16_t* H1 = PROJ;
    bf16_t* Yb = (bf16_t*)(a.ws + WS_Y); bf16_t* YP = (bf16_t*)(a.ws + WS_YP); float* GATES = (float*)(a.ws + WS_GATES);
    if (IN(0)) for (int rep = 0; rep <= REP_P0; ++rep) {
        colmax_phase(a, (LAS float*)lds);
        for (int r_ = 0; r_ <= REP_MODS; ++r_) mods_phase(a, (LAS float*)lds);
    }
    SYNC(0);
    if (IN(1)) { for (int rep = 0; rep <= REP_ROW0; ++rep) row_phase<0>(a, 0, MT, true, (LAS float*)lds); __syncthreads(); for (int r_ = 0; r_ <= REP_CV; ++r_) convert_layer(a, 0, lds); }
    SYNC(1);
    for (int l = 0; l < DEPTH; ++l) {
        const bool last = (l == DEPTH - 1); const int M2 = last ? MX : MT, pb = 2 + 8 * l;
        const bf16_t* wl = (const bf16_t*)(a.ws + WS_W);
        const bf16_t* WIN = wl; const bf16_t* WOUT = (const bf16_t*)((const unsigned char*)wl + SZ_WIN);
        const bf16_t* WF1 = (const bf16_t*)((const unsigned char*)wl + SZ_WIN + SZ_WOUT); const bf16_t* WF2 = (const bf16_t*)((const unsigned char*)wl + SZ_WIN + SZ_WOUT + SZ_WFF);
        if (IN(pb)) for (int rep = 0; rep <= REP_GEMM + REP_G0; ++rep) { pg8::Gemm g{HX, WIN, MT, DINP, D}; pg8::TailTilesOrder S; S.init(last ? MX : MT, DINP, D, last ? 64 : 0, 8, C_K / 256, (int)gridDim.x, (int)blockIdx.x);     pg8::EpiBf16<0> E{PROJ, DP, GATES, C_G / 256, (bf16_t*)(a.ws + WS_QKVH), MT}; pg8::gemm_phase(lds, g, S, E); }
        SYNC(pb);
        if (IN(pb + 1)) {
#ifndef SKIP_ML
 for (int rep = 0; rep <= REP_ML; ++rep) mlstm_phase(a, l, last, lds);
#endif
for (int rep = 0; rep <= REP_MIX + REP_CA; ++rep) conva_phase(a, l, last ? 256 : 288, (LAS float*)lds);
 for (int rep = 0; rep <= REP_MIX + REP_SC; ++rep) shortconv_phase(a, l, M2);
 }
        SYNC(pb + 1);
        if (IN(pb + 2)) for (int rep = 0; rep <= REP_MIX + REP_MO; ++rep) mlstm_out_phase(a, l, M2);
        SYNC(pb + 2);
        if (IN(pb + 3)) for (int rep = 0; rep <= REP_GEMM + REP_G1; ++rep) { pg8::Gemm g{MIX, WOUT, M2, D, D}; pg8::TailSplitOrder S; S.init(MX, D, D, last ? 0 : MC / 256, (int)gridDim.x, (int)blockIdx.x); pg8::EpiY E{Yb, D, YP, MX, (size_t)MC * D}; pg8::gemm_phase(lds, g, S, E); }
        SYNC(pb + 3);
        if (IN(pb + 4)) row_phase<1>(a, l, M2, true, (LAS float*)lds);
        SYNC(pb + 4);
        if (IN(pb + 5)) for (int rep = 0; rep <= REP_GEMM + REP_G2; ++rep) {
            pg8::Gemm g{HX, WF1, M2, DFF, D / 2}; pg8::StaticOrder S; S.init(M2, DFF, D / 2, (int)gridDim.x, (int)blockIdx.x);
            pg8::EpiSqReluI8 E{H1, DFF, (const float*)(a.ws + WS_RSC), (const float*)(a.ws + WS_CSC) + (size_t)l * DFF}; pg8::gemm_phase(lds, g, S, E); }
        SYNC(pb + 5);
        if (IN(pb + 6)) for (int rep = 0; rep <= REP_GEMM + REP_G3; ++rep) { pg8::Gemm g{H1, WF2, M2, D, DFF}; pg8::TailSplitOrder S; S.init(MX, D, DFF, last ? 0 : MC / 256, (int)gridDim.x, (int)blockIdx.x); S.base.wgm = 4;     pg8::EpiY E{Yb, D, YP, MX, (size_t)MC * D}; pg8::gemm_phase(lds, g, S, E); }
        SYNC(pb + 6);
        if (IN(pb + 7)) { row_phase<2>(a, l, M2, !last, (LAS float*)lds); __syncthreads(); if (!last) convert_layer(a, l + 1, lds); }
        SYNC(pb + 7);
    }
#undef IN
#undef SYNC
}

extern "C" void kernel_launch(void* const* d_in, const int* in_sizes, int n_in, void* d_out, int out_size, void* d_ws, size_t ws_size, hipStream_t stream) {
    static int grid = 0;
    if (grid == 0) {
        if (n_in != 21 || in_sizes[0] != MX * D || out_size != MX * D || ws_size < WS_END) { fprintf(stderr, "kernel_launch: unexpected shapes / workspace (n_in %d, ws %zu, need %zu)\n", n_in, ws_size, (size_t)WS_END); grid = -1; return; }
        int dev = 0, cus = 0, per_cu = 0;
        hipGetDevice(&dev); hipDeviceGetAttribute(&cus, hipDeviceAttributeMultiprocessorCount, dev);
        if (hipFuncSetAttribute((const void*)mega, hipFuncAttributeMaxDynamicSharedMemorySize, LDS_BYTES) != hipSuccess) { fprintf(stderr, "kernel_launch: hipFuncSetAttribute failed\n"); grid = -1; return; }
        if (hipOccupancyMaxActiveBlocksPerMultiprocessor(&per_cu, (const void*)mega, 512, LDS_BYTES) != hipSuccess || per_cu < 1) per_cu = 1;
        (void)hipGetLastError();
        grid = cus * 1;
    }
    if (grid < 0) return;
    Args a{};
    for (int i = 0; i < 21; ++i) a.in[i] = (const float*)d_in[i];
    a.out = (float*)d_out; a.ws = (unsigned char*)d_ws;
#if SINGLE_LAUNCH
    if (hipMemsetAsync((unsigned char*)d_ws + WS_BAR, 0, 16384, stream) != hipSuccess) { fprintf(stderr, "kernel_launch: memset failed\n"); return; }
    a.ph_lo = 0; a.ph_hi = NPH;
    void* args[] = {&a};
    hipError_t e = hipLaunchCooperativeKernel((const void*)mega, dim3(grid), dim3(512), args, LDS_BYTES, stream);
    if (e != hipSuccess) fprintf(stderr, "cooperative launch failed: %s (grid %d)\n", hipGetErrorString(e), grid);
#else
    for (int p = 0; p < NPH; ++p) { a.ph_lo = p; a.ph_hi = p + 1; hipLaunchKernelGGL(mega, dim3(grid), dim3(512), LDS_BYTES, stream, a); }
#endif
}
```
